# Optimizing an MI355X kernel written in HIP

```python
import jax, jax.numpy as jnp
from jax import lax
import numpy as np

D_MODEL = 2048
BATCH = 4
SEQ = 2048
DEPTH = 1
DEC_BATCH = 8
DEC_SEQ = 4
PAST_LEN = 16384
PAGE_SIZE = 128

HEAD_DIM = 128
CONV_DIM = D_MODEL // 4
CONV_W = 3
NSA_WIDTH = D_MODEL // 2
NSA_HEADS = NSA_WIDTH // HEAD_DIM
NSA_KV = 2
NSA_HPG = NSA_HEADS // NSA_KV
KV_WIDTH = NSA_KV * HEAD_DIM
MEM_HEADS = 4
MEM_WIDTH = MEM_HEADS * HEAD_DIM
N_MEM = 256
MIX_WIDTH = CONV_DIM + NSA_WIDTH + MEM_WIDTH
ROPE_DIM = HEAD_DIM // 4
ROPE_THETA = 500000.0
CMP_BLOCK = 64
SEL_BLOCK = 64
TOP_N = 16
WINDOW = 512
Q_BLOCK = 128
N_BRANCH = 3
N_KV_PARTS = 4
NORM_EPS = 1e-6
MASK_NEG = -1e30
FORCE = 1e9
ATTN_SCALE = HEAD_DIM ** -0.5

IN_SPLITS = (CONV_DIM, CONV_DIM, CONV_DIM, CONV_DIM,
             NSA_WIDTH, NSA_WIDTH, NSA_HEADS * N_BRANCH,
             KV_WIDTH * 6,
             MEM_WIDTH, MEM_WIDTH)
IN_WIDTH = sum(IN_SPLITS)

kernel_name = 'hymba_conv_nsa_mem_decode_step'


def rms_norm(x, g):
    xf = x.astype(jnp.float32)
    y = xf * lax.rsqrt(jnp.mean(xf * xf, axis=-1, keepdims=True) + NORM_EPS)
    return (y * g.astype(jnp.float32)).astype(x.dtype)


def rope(x, pos):
    half = ROPE_DIM // 2
    freqs = jnp.power(ROPE_THETA, -jnp.arange(half, dtype=jnp.float32) * (2.0 / ROPE_DIM))
    ang = pos.astype(jnp.float32)[:, None] * freqs[None, :]
    cos = jnp.cos(ang)[:, None, :]
    sin = jnp.sin(ang)[:, None, :]
    xf = x.astype(jnp.float32)
    x1 = xf[..., :half]
    x2 = xf[..., half:ROPE_DIM]
    out = jnp.concatenate([x1 * cos - x2 * sin, x2 * cos + x1 * sin, xf[..., ROPE_DIM:]], axis=-1)
    return out.astype(x.dtype)


def masked_softmax(s, mask, axis=-1):
    s = jnp.where(mask, s.astype(jnp.float32), MASK_NEG)
    p = jax.nn.softmax(s, axis=axis)
    return jnp.where(mask, p, 0.0)


def split_cols(z):
    idx = np.cumsum(IN_SPLITS)[:-1].tolist()
    return jnp.split(z, idx, axis=-1)


def gqa_attend(q, k, v, mask):
    B, T, H, D = q.shape
    G = k.shape[2]
    qg = q.reshape(B, T, G, H // G, D)
    s = jnp.einsum('btghd,bsgd->btghs', qg, k) * ATTN_SCALE
    if mask is None:
        p = jax.nn.softmax(s.astype(jnp.float32), axis=-1)
    else:
        p = masked_softmax(s, mask)
    o = jnp.einsum('btghs,bsgd->btghd', p.astype(v.dtype), v)
    return o.reshape(B, T, H, D)


def short_conv_mixer(h, b, c, conv_prev, w_conv):
    T = h.shape[1]
    u = c * h
    up = jnp.concatenate([conv_prev.astype(u.dtype), u], axis=1)
    y = w_conv[0] * up[:, 0:T]
    for j in range(1, CONV_W):
        y = y + w_conv[j] * up[:, j:j + T]
    return b * y, up[:, T:]


def compress(kv, a, w):
    B, L = kv.shape[:2]
    n = L // CMP_BLOCK
    blocks = kv[:, :n * CMP_BLOCK].reshape(B, n, CMP_BLOCK, NSA_KV, HEAD_DIM)
    pooled = jnp.einsum('bnjgd,jd->bngd', blocks, a)
    return jnp.einsum('bngd,de->bnge', pooled, w)


def nsa_cmp_sel(q, q_rot, q_pos, k_cmp, v_cmp, k_sel, v_sel):
    B, T = q.shape[:2]
    L = k_sel.shape[1]
    n_cmp = k_cmp.shape[1]
    n_sel = -(-L // SEL_BLOCK)
    top = min(TOP_N, n_sel)
    pad = n_sel * SEL_BLOCK - L
    padw = ((0, 0), (0, pad), (0, 0), (0, 0))
    kb = jnp.pad(k_sel, padw).reshape(B, n_sel, SEL_BLOCK, NSA_KV, HEAD_DIM).transpose(0, 3, 1, 2, 4)
    vb = jnp.pad(v_sel, padw).reshape(B, n_sel, SEL_BLOCK, NSA_KV, HEAD_DIM).transpose(0, 3, 1, 2, 4)
    cmp_end = (jnp.arange(n_cmp, dtype=jnp.int32) + 1) * CMP_BLOCK
    blk = jnp.arange(n_sel, dtype=jnp.int32)
    bidx = jnp.arange(B)[:, None, None, None]
    gidx = jnp.arange(NSA_KV)[None, :, None, None]
    qb = Q_BLOCK if T % Q_BLOCK == 0 else T
    nq = T // qb

    def one_block(args):
        qc, qrc, pc = args
        qg = qc.reshape(B, qb, NSA_KV, NSA_HPG, HEAD_DIM)
        s = jnp.einsum('btghd,bngd->btghn', qg, k_cmp) * ATTN_SCALE
        cmask = (cmp_end[None, :] <= pc[:, None] + 1)[None, :, None, None, :]
        p = masked_softmax(s, cmask)
        o_c = jnp.einsum('btghn,bngd->btghd', p.astype(v_cmp.dtype), v_cmp)
        imp = jnp.pad(p.sum(axis=3), ((0, 0), (0, 0), (0, 0), (0, n_sel - n_cmp)))
        cur = (pc // SEL_BLOCK)[:, None]
        forced = (blk[None] == 0) | (blk[None] == cur) | (blk[None] == cur - 1)
        imp = jnp.where(forced[None, :, None, :], FORCE, imp)
        imp = jnp.where((blk[None] > cur)[None, :, None, :], -1.0, imp)
        _, idx = lax.top_k(imp, top)
        idx = idx.transpose(0, 2, 1, 3)
        kg = kb[bidx, gidx, idx]
        vg = vb[bidx, gidx, idx]
        qrg = qrc.reshape(B, qb, NSA_KV, NSA_HPG, HEAD_DIM).transpose(0, 2, 1, 3, 4)
        s2 = jnp.einsum('bgthd,bgtkjd->bgthkj', qrg, kg) * ATTN_SCALE
        kpos = idx[..., None] * SEL_BLOCK + jnp.arange(SEL_BLOCK, dtype=jnp.int32)
        smask = (kpos <= pc[None, None, :, None, None])[:, :, :, None]
        p2 = masked_softmax(s2, smask, axis=(-2, -1))
        o_s = jnp.einsum('bgthkj,bgtkjd->bgthd', p2.astype(vg.dtype), vg)
        o_c = o_c.reshape(B, qb, NSA_HEADS, HEAD_DIM)
        o_s = o_s.transpose(0, 2, 1, 3, 4).reshape(B, qb, NSA_HEADS, HEAD_DIM)
        return o_c, o_s

    def split(a):
        return a.reshape(B, nq, qb, *a.shape[2:]).swapaxes(0, 1)

    o_c, o_s = lax.map(one_block, (split(q), split(q_rot), q_pos.reshape(nq, qb)))

    def merge(a):
        return a.swapaxes(0, 1).reshape(B, T, NSA_HEADS, HEAD_DIM)

    return merge(o_c), merge(o_s)


def window_banded(q_rot, k, v):
    B, T = q_rot.shape[:2]
    nb = T // Q_BLOCK
    nw = WINDOW // Q_BLOCK
    padw = ((0, 0), (WINDOW, 0), (0, 0), (0, 0))
    kp = jnp.pad(k, padw).reshape(B, nb + nw, Q_BLOCK, NSA_KV, HEAD_DIM)
    vp = jnp.pad(v, padw).reshape(B, nb + nw, Q_BLOCK, NSA_KV, HEAD_DIM)
    ks = jnp.concatenate([kp[:, j:j + nb] for j in range(nw + 1)], axis=2)
    vs = jnp.concatenate([vp[:, j:j + nb] for j in range(nw + 1)], axis=2)
    qpos = jnp.arange(T, dtype=jnp.int32).reshape(nb, Q_BLOCK)
    kpos = (jnp.arange(nb, dtype=jnp.int32)[:, None] * Q_BLOCK - WINDOW) + jnp.arange((nw + 1) * Q_BLOCK, dtype=jnp.int32)[None]
    kq = kpos[:, None, :]
    mask = (kq >= 0) & (kq <= qpos[:, :, None]) & (kq > qpos[:, :, None] - WINDOW)
    qg = q_rot.reshape(B, nb, Q_BLOCK, NSA_KV, NSA_HPG, HEAD_DIM)
    s = jnp.einsum('bnqghd,bnsgd->bnqghs', qg, ks) * ATTN_SCALE
    p = masked_softmax(s, mask[None, :, :, None, None, :])
    o = jnp.einsum('bnqghs,bnsgd->bnqghd', p.astype(vs.dtype), vs)
    return o.reshape(B, T, NSA_HEADS, HEAD_DIM)


def decoder_layer(x, past_kv, win_prev, conv_prev, mem_kv, norm_g, w_in, w_conv, a_cmp, w_cmp, w_out):
    B, T, _ = x.shape
    start = 0 if past_kv is None else past_kv.shape[1]
    pos = start + jnp.arange(T, dtype=jnp.int32)
    h = rms_norm(x, norm_g)
    c_h, c_b, c_c, c_g, q, n_g, b_g, kv6, m_q, m_g = split_cols(h @ w_in)

    y_a, conv_new = short_conv_mixer(c_h, c_b, c_c, conv_prev, w_conv)
    y_a = jax.nn.silu(c_g) * y_a

    q = q.reshape(B, T, NSA_HEADS, HEAD_DIM)
    q_rot = rope(q, pos)
    kv6 = kv6.reshape(B, T, 6, NSA_KV, HEAD_DIM)
    kv_new = jnp.stack([kv6[:, :, 0], kv6[:, :, 1], rope(kv6[:, :, 2], pos), kv6[:, :, 3]], axis=2)
    win_new = jnp.stack([rope(kv6[:, :, 4], pos), kv6[:, :, 5]], axis=2)
    kv_all = kv_new if past_kv is None else jnp.concatenate([past_kv.astype(kv_new.dtype), kv_new], axis=1)
    k_cmp = compress(kv_all[:, :, 0], a_cmp[0], w_cmp[0])
    v_cmp = compress(kv_all[:, :, 1], a_cmp[1], w_cmp[1])
    o_cmp, o_sel = nsa_cmp_sel(q, q_rot, pos, k_cmp, v_cmp, kv_all[:, :, 2], kv_all[:, :, 3])
    if win_prev is None:
        o_win = window_banded(q_rot, win_new[:, :, 0], win_new[:, :, 1])
        win_state = win_new[:, T - min(WINDOW, T):]
    else:
        win_all = jnp.concatenate([win_prev.astype(win_new.dtype), win_new], axis=1)
        S = win_all.shape[1]
        kpos = start + T - S + jnp.arange(S, dtype=jnp.int32)
        wmask = (kpos[None, :] <= pos[:, None]) & (kpos[None, :] > pos[:, None] - WINDOW)
        o_win = gqa_attend(q_rot, win_all[:, :, 0], win_all[:, :, 1], wmask[None, :, None, None, :])
        win_state = win_all[:, S - win_prev.shape[1]:]
    g = jax.nn.sigmoid(b_g.astype(jnp.float32)).reshape(B, T, NSA_HEADS, N_BRANCH).astype(x.dtype)
    o_nsa = g[..., 0:1] * o_cmp + g[..., 1:2] * o_sel + g[..., 2:3] * o_win
    y_b = jax.nn.silu(n_g) * o_nsa.reshape(B, T, NSA_WIDTH)

    o_m = gqa_attend(m_q.reshape(B, T, MEM_HEADS, HEAD_DIM), mem_kv[:, :, 0], mem_kv[:, :, 1], None)
    y_m = jax.nn.silu(m_g) * o_m.reshape(B, T, MEM_WIDTH)

    mixed = jnp.concatenate([y_a, y_b, y_m], axis=-1)
    return x + mixed @ w_out, kv_new, win_state, conv_new


def setup_inputs(seed: int = 0) -> dict:
    key = jax.random.key(seed)
    ks = jax.random.split(key, 18)
    f32 = jnp.float32
    n_pages = PAST_LEN // PAGE_SIZE
    n_pool = (DEC_BATCH * n_pages * 5) // 4
    w_buf = min(WINDOW, PAST_LEN)

    def nrm(k, shape, s=1.0):
        return jax.random.normal(k, shape, f32) * s

    perm = jax.random.permutation(ks[6], n_pool)
    return {
        'x_prompt': nrm(ks[0], (BATCH, SEQ, D_MODEL)),
        'x_sample': nrm(ks[1], (DEC_BATCH, DEC_SEQ, D_MODEL)),
        'cache_kv': nrm(ks[2], (DEPTH, n_pool, PAGE_SIZE, N_KV_PARTS, NSA_KV, HEAD_DIM)),
        'cache_win': nrm(ks[3], (DEPTH, DEC_BATCH, w_buf, 2, NSA_KV, HEAD_DIM)),
        'state_conv': nrm(ks[4], (DEPTH, DEC_BATCH, CONV_W - 1, CONV_DIM)),
        'cache_mem': nrm(ks[5], (DEPTH, DEC_BATCH, N_MEM, 2, MEM_HEADS, HEAD_DIM)),
        'page_table': perm[:DEC_BATCH * n_pages].reshape(DEC_BATCH, n_pages).astype(jnp.int32),
        'mem_prompt': nrm(ks[7], (BATCH, N_MEM, D_MODEL)),
        'norm_g': 1.0 + nrm(ks[8], (DEPTH, D_MODEL), 0.02),
        'w_in': nrm(ks[9], (DEPTH, D_MODEL, IN_WIDTH), D_MODEL ** -0.5),
        'w_conv': nrm(ks[10], (DEPTH, CONV_W, CONV_DIM), CONV_W ** -0.5),
        'a_cmp': nrm(ks[11], (DEPTH, 2, CMP_BLOCK, HEAD_DIM), CMP_BLOCK ** -0.5),
        'w_cmp': nrm(ks[12], (DEPTH, 2, HEAD_DIM, HEAD_DIM), HEAD_DIM ** -0.5),
        'mem_norm_g': 1.0 + nrm(ks[13], (DEPTH, D_MODEL), 0.02),
        'w_mem_kv': nrm(ks[14], (DEPTH, D_MODEL, 2 * MEM_WIDTH), D_MODEL ** -0.5),
        'w_out': nrm(ks[15], (DEPTH, MIX_WIDTH, D_MODEL), MIX_WIDTH ** -0.5),
        'final_g': 1.0 + nrm(ks[16], (D_MODEL,), 0.02),
    }


def reference(x_prompt, x_sample, cache_kv, cache_win, state_conv, cache_mem, page_table, mem_prompt,
              norm_g, w_in, w_conv, a_cmp, w_cmp, mem_norm_g, w_mem_kv, w_out, final_g):
    xp, xs = x_prompt, x_sample
    kv_p, win_p, conv_p, mem_p, kv_s, win_s, conv_s = [], [], [], [], [], [], []
    for l in range(DEPTH):
        lw = (norm_g[l], w_in[l], w_conv[l], a_cmp[l], w_cmp[l], w_out[l])
        mkv = (rms_norm(mem_prompt, mem_norm_g[l]) @ w_mem_kv[l]).reshape(
            mem_prompt.shape[0], N_MEM, 2, MEM_HEADS, HEAD_DIM)
        conv0 = jnp.zeros((xp.shape[0], CONV_W - 1, CONV_DIM), xp.dtype)
        xp, kvn, winn, convn = decoder_layer(xp, None, None, conv0, mkv, *lw)
        kv_p.append(kvn)
        win_p.append(winn)
        conv_p.append(convn)
        mem_p.append(mkv)
        past = cache_kv[l][page_table]
        past = past.reshape(past.shape[0], past.shape[1] * past.shape[2], *past.shape[3:])
        xs, kvn, winn, convn = decoder_layer(xs, past, cache_win[l], state_conv[l], cache_mem[l], *lw)
        kv_s.append(kvn)
        win_s.append(winn)
        conv_s.append(convn)
    y_prompt = rms_norm(xp, final_g)
    y_sample = rms_norm(xs, final_g)
    return (y_prompt, y_sample, jnp.stack(kv_p), jnp.stack(win_p), jnp.stack(conv_p), jnp.stack(mem_p),
            jnp.stack(kv_s), jnp.stack(win_s), jnp.stack(conv_s))
```

```cpp
#include <hip/hip_runtime.h>
#include <hip/hip_cooperative_groups.h>
#include <cstdio>
#include <cstdint>
namespace cg = cooperative_groups;

constexpr int DM = 2048, PB = 4, PT = 2048, MP = PB * PT, SBATCH = 8, STOK = 4, MS = SBATCH * STOK, MALL = MP + MS, MPAD = 8448;
constexpr int INW = 6680, ZLD = 6912;
constexpr int ZC_CH = 0, ZC_CB = 512, ZC_CC = 1024, ZC_CG = 1536, ZC_Q = 2048, ZC_NG = 3072, ZC_KV = 4096, ZC_MQ = 5632, ZC_MG = 6144, ZC_BG = 6656;
constexpr int PAST = 16384, NPAGES = 128;
constexpr float NORM_EPS = 1e-6f;
constexpr size_t OFF_YP = 0, OFF_YS = OFF_YP + (size_t)MP * DM, OFF_KVP = OFF_YS + (size_t)MS * DM, OFF_WINP = OFF_KVP + (size_t)MP * 1024,
                 OFF_CONVP = OFF_WINP + (size_t)PB * 512 * 512, OFF_MEMP = OFF_CONVP + (size_t)PB * 2 * 512, OFF_KVS = OFF_MEMP + (size_t)PB * 256 * 1024,
                 OFF_WINS = OFF_KVS + (size_t)MS * 1024, OFF_CONVS = OFF_WINS + (size_t)SBATCH * 512 * 512, OFF_END = OFF_CONVS + (size_t)SBATCH * 2 * 512;
constexpr size_t MiB = 1u << 20;
constexpr size_t WS_CTL = 0, CTL_BYTES = 1 * MiB;
constexpr size_t WS_WIN = 1 * MiB, WS_WOUT = 28 * MiB, WS_WMEM = 36 * MiB, WS_HN = 40 * MiB, WS_HM = 73 * MiB, WS_Z = 77 * MiB, WS_MIX = 189 * MiB,
                 WS_MKV = 222 * MiB, WS_QNR = 224 * MiB, WS_POOLP = 229 * MiB, WS_POOLS = 230 * MiB, WS_KCP = 234 * MiB, WS_VCP = WS_KCP + 131072,
                 WS_KCS = 235 * MiB, WS_VCS = 236 * MiB, WS_ROPE = 237 * MiB, WS_TOT = 238 * MiB, WS_END = 254 * MiB;
static_assert(WS_WIN + (size_t)ZLD * DM * 2 <= WS_WOUT && WS_HN + (size_t)MPAD * DM * 2 <= WS_HM && WS_Z + (size_t)MPAD * ZLD * 2 <= WS_MIX && WS_MIX + (size_t)MPAD * DM * 2 <= WS_MKV &&
              WS_QNR + (size_t)MPAD * 256 * 2 <= WS_POOLP && WS_POOLS + (size_t)SBATCH * 256 * 512 * 4 <= WS_KCP && WS_ROPE + 2052 * 32 * 4 <= WS_TOT && WS_TOT + (size_t)256 * 4 * 4096 * 4 <= WS_END, "ws map");

constexpr int NWAVES = 8, NTHREADS = 512;
constexpr int LDS_BYTES = 159744;

#define LAS __attribute__((address_space(3)))
typedef LAS unsigned char lbyte;
namespace pg8 {
#define PG8_LAS __attribute__((address_space(3)))
typedef unsigned short bf16_t;
typedef short bf16x8 __attribute__((ext_vector_type(8)));
typedef float f32x4 __attribute__((ext_vector_type(4)));
typedef unsigned u32x4 __attribute__((ext_vector_type(4)));
constexpr int BM = 256, BK = 64, HALF = 128, HTB = HALF * BK * 2  , STAGE_BYTES = 8 * HTB, NXCD = 8, WGM = 8;

__host__ __device__ __forceinline__ int lds_byte(int r, int c) { const int st = (r >> 4) * 2 + (c >> 5), rr = r & 15, cc = c & 31, ob = rr * 64 + cc * 2; return st * 1024 + (ob ^ (((ob >> 9) & 1) << 5)); }
__host__ __device__ __forceinline__ void stage_rc(int b, int& R, int& C) { const int st = b / 1024, sb = b % 1024, swz = sb ^ (((sb >> 9) & 1) << 5); R = (st >> 1) * 16 + swz / 64; C = (st & 1) * 32 + (swz % 64) / 2; }
__host__ __device__ __forceinline__ int perm32(int rho) { const int n = rho >> 4, i = rho & 15; return 8 * (i >> 2) + 4 * n + (i & 3); }

struct Unit { int pm, pn; };
struct Gemm { const bf16_t* A; const bf16_t* Bt; int M, N, K; };

struct StaticOrder {
    int nM, nN, nwg, G, c;
    __host__ __device__ void init(int M, int N, int G_, int c_) { nM = M / BM; nN = N / BM; nwg = nM * nN; G = G_; c = c_; }
    __host__ __device__ bool next(int i, Unit& u) const {
        const long L = (long)i * G + c; if (L >= nwg) return false;
        int wgid = (int)L; { const int q = nwg / NXCD, r = nwg % NXCD, xcd = wgid % NXCD, off = wgid / NXCD; wgid = (xcd < r ? xcd * (q + 1) : r * (q + 1) + (xcd - r) * q) + off; }
        const int nig = WGM * nN, gid = wgid / nig, fm = gid * WGM, gsz = (nM - fm) < WGM ? (nM - fm) : WGM;
        u.pm = fm + ((wgid % nig) % gsz); u.pn = (wgid % nig) / gsz; return true;
    }
    __device__ __forceinline__ void a_ready(const Unit&) const {}
    __device__ __forceinline__ void done(const Unit&) const {}
};

__device__ __forceinline__ unsigned cvt_pk_bf16(float lo, float hi) { unsigned r; asm volatile("v_cvt_pk_bf16_f32 %0, %1, %2" : "=v"(r) : "v"(lo), "v"(hi)); return r; }
typedef float f32x2 __attribute__((ext_vector_type(2)));
template <class Epi, class Sched, bool ALIGN_EPI = false, bool SP2 = false>
__device__ __forceinline__ void gemm_phase(PG8_LAS unsigned char* lds, const Gemm g, const Sched& S, const Epi& E) {
    const int tid = threadIdx.x, wid = __builtin_amdgcn_readfirstlane(tid >> 6), lane = tid & 63, wr = wid >> 2, wc = wid & 3, fr = lane & 15, fq = lane >> 4;
    const int K = g.K, nt = K / BK;
    unsigned voffA[2], voffB[2];
#pragma unroll
    for (int i = 0; i < 2; ++i) { int R, C; stage_rc(tid * 16 + i * 8192, R, C); const int Rb = Epi::PERM ? ((R & ~31) + perm32(R & 31)) : R;
        voffA[i] = (unsigned)(R * K + C) * 2u; voffB[i] = (unsigned)(Rb * K + C) * 2u; }
    const size_t kstep = (size_t)(BK * 2);
    const size_t hstep = (size_t)HALF * K * 2;
    const size_t tstep = 2 * hstep;
    const unsigned ldsw = (unsigned)wid * 1024u;
    const int aoff = lds_byte(wr * 64 + fr, fq * 8), boff = lds_byte(wc * 32 + fr, fq * 8);
#define PG8_SA(b, h) (((b) * 2 + (h)) * HTB)
#define PG8_SB(b, h) ((4 + (b) * 2 + (h)) * HTB)
#define PG8_STAGE(bufoff, gbase, voff) do { _Pragma("unroll") for (int _i = 0; _i < 2; ++_i) \
        __builtin_amdgcn_global_load_lds((const unsigned*)((const char*)(gbase) + (voff)[_i]), (PG8_LAS unsigned*)(lds + (bufoff) + ldsw + _i * 8192), 16, 0, 0); } while (0)
#define PG8_LDA(dst, b, h) do { _Pragma("unroll") for (int m = 0; m < 4; ++m) _Pragma("unroll") for (int k = 0; k < 2; ++k) dst[m][k] = *(const PG8_LAS bf16x8*)(lds + PG8_SA(b, h) + aoff + m * 2048 + k * 1024); } while (0)
#define PG8_LDB(dst, b, h) do { _Pragma("unroll") for (int n = 0; n < 2; ++n) _Pragma("unroll") for (int k = 0; k < 2; ++k) dst[n][k] = *(const PG8_LAS bf16x8*)(lds + PG8_SB(b, h) + boff + n * 2048 + k * 1024); } while (0)
#define PG8_MMA(ai, bj, At, Bt) do { __builtin_amdgcn_s_setprio(1); _Pragma("unroll") for (int m = 0; m < 4; ++m) _Pragma("unroll") for (int n = 0; n < 2; ++n) _Pragma("unroll") for (int k = 0; k < 2; ++k) \
        acc[ai][bj][m][n] = __builtin_amdgcn_mfma_f32_16x16x32_bf16(Bt[n][k], At[m][k], acc[ai][bj][m][n], 0, 0, 0); __builtin_amdgcn_s_setprio(0); } while (0)
#define PG8_WAIT_V(n) asm volatile("s_waitcnt vmcnt(" #n ")" ::: "memory")
#define PG8_WAIT_L(n) asm volatile("s_waitcnt lgkmcnt(" #n ")" ::: "memory")
#define PG8_BAR __builtin_amdgcn_s_barrier()
#define PG8_SCHED __builtin_amdgcn_sched_barrier(0)
    Unit cur, nxt; int ui = 0;
    if (!S.next(0, cur)) return;
    f32x4 acc[2][2][4][2];
#pragma unroll
    for (int a = 0; a < 2; ++a)
#pragma unroll
        for (int b = 0; b < 2; ++b)
#pragma unroll
            for (int m = 0; m < 4; ++m)
#pragma unroll
                for (int n = 0; n < 2; ++n) acc[a][b][m][n] = (f32x4){0.f, 0.f, 0.f, 0.f};
    bf16x8 At[4][2], B0[2][2], B1[2][2];
    const char* cA = (const char*)g.A + (size_t)cur.pm * tstep; const char* cB = (const char*)g.Bt + (size_t)cur.pn * tstep;
    S.a_ready(cur);
    if constexpr (SP2) {
        PG8_STAGE(PG8_SB(0, 0), cB, voffB); PG8_STAGE(PG8_SB(0, 1), cB + hstep, voffB); PG8_STAGE(PG8_SA(0, 0), cA, voffA); PG8_STAGE(PG8_SA(0, 1), cA + hstep, voffA);
        if (wr == 1) PG8_BAR;
        PG8_WAIT_V(2); PG8_BAR;
        PG8_STAGE(PG8_SB(1, 0), cB + kstep, voffB); PG8_STAGE(PG8_SA(1, 0), cA + kstep, voffA); PG8_STAGE(PG8_SB(1, 1), cB + hstep + kstep, voffB);
        PG8_WAIT_V(6); PG8_BAR;
    } else {
        PG8_STAGE(PG8_SB(0, 0), cB, voffB); PG8_STAGE(PG8_SA(0, 0), cA, voffA); PG8_STAGE(PG8_SB(0, 1), cB + hstep, voffB); PG8_STAGE(PG8_SA(0, 1), cA + hstep, voffA);
        if (wr == 1) PG8_BAR;
        PG8_WAIT_V(4); PG8_BAR;
        PG8_STAGE(PG8_SB(1, 0), cB + kstep, voffB); PG8_STAGE(PG8_SA(1, 0), cA + kstep, voffA); PG8_STAGE(PG8_SB(1, 1), cB + hstep + kstep, voffB);
        PG8_WAIT_V(6); PG8_BAR;
    }
    for (;;) {
        const bool has_next = S.next(ui + 1, nxt);
        const char* nA = has_next ? (const char*)g.A + (size_t)nxt.pm * tstep : cA; const char* nB = has_next ? (const char*)g.Bt + (size_t)nxt.pn * tstep : cB;
        for (int t = 0; t < nt; t += 2) {
            const bool last = (t == nt - 2);
            const char* a1 = cA + (size_t)(t + 1) * kstep;
            const char* a2 = last ? nA : cA + (size_t)(t + 2) * kstep; const char* b2 = last ? nB : cB + (size_t)(t + 2) * kstep;
            const char* a3 = a2 + kstep; const char* b3 = b2 + kstep;
            if (last && has_next) S.a_ready(nxt);
            if constexpr (SP2) {
            PG8_LDB(B0, 0, 0); PG8_LDB(B1, 0, 1); PG8_SCHED; PG8_LDA(At, 0, 0); PG8_STAGE(PG8_SA(1, 1), a1 + hstep, voffA);
            PG8_WAIT_V(8); PG8_WAIT_L(0); PG8_BAR; PG8_MMA(0, 0, At, B0); PG8_MMA(0, 1, At, B1); PG8_BAR; PG8_SCHED;
            PG8_LDA(At, 0, 1); PG8_STAGE(PG8_SB(0, 0), b2, voffB); PG8_STAGE(PG8_SB(0, 1), b2 + hstep, voffB); PG8_STAGE(PG8_SA(0, 0), a2, voffA);
            PG8_WAIT_V(8); PG8_WAIT_L(0); PG8_BAR; PG8_MMA(1, 0, At, B0); PG8_MMA(1, 1, At, B1); PG8_BAR; PG8_SCHED;
            PG8_LDB(B0, 1, 0); PG8_LDB(B1, 1, 1); PG8_SCHED; PG8_LDA(At, 1, 0); PG8_STAGE(PG8_SA(0, 1), a2 + hstep, voffA);
            PG8_WAIT_V(8); PG8_WAIT_L(0); PG8_BAR; PG8_MMA(0, 0, At, B0); PG8_MMA(0, 1, At, B1); PG8_BAR; PG8_SCHED;
            PG8_LDA(At, 1, 1); PG8_STAGE(PG8_SB(1, 0), b3, voffB); PG8_STAGE(PG8_SB(1, 1), b3 + hstep, voffB); PG8_STAGE(PG8_SA(1, 0), a3, voffA);
            PG8_WAIT_V(8); PG8_WAIT_L(0); PG8_BAR; PG8_MMA(1, 0, At, B0); PG8_MMA(1, 1, At, B1); PG8_BAR; PG8_SCHED;
            } else {
            PG8_LDB(B0, 0, 0); PG8_SCHED; PG8_LDA(At, 0, 0); PG8_STAGE(PG8_SA(1, 1), a1 + hstep, voffA);
            PG8_WAIT_L(8); PG8_BAR; PG8_WAIT_L(0); PG8_MMA(0, 0, At, B0); PG8_BAR; PG8_SCHED;
            PG8_LDB(B1, 0, 1); PG8_STAGE(PG8_SB(0, 0), b2, voffB);
            PG8_BAR; PG8_WAIT_L(0); PG8_MMA(0, 1, At, B1); PG8_BAR;
            PG8_LDA(At, 0, 1); PG8_STAGE(PG8_SA(0, 0), a2, voffA);
            PG8_BAR; PG8_WAIT_L(0); PG8_MMA(1, 0, At, B0); PG8_BAR; PG8_SCHED;
            PG8_STAGE(PG8_SB(0, 1), b2 + hstep, voffB);
            PG8_WAIT_V(6); PG8_BAR; PG8_MMA(1, 1, At, B1); PG8_BAR;
            PG8_LDB(B0, 1, 0); PG8_SCHED; PG8_LDA(At, 1, 0); PG8_STAGE(PG8_SA(0, 1), a2 + hstep, voffA);
            PG8_WAIT_L(8); PG8_BAR; PG8_WAIT_L(0); PG8_MMA(0, 0, At, B0); PG8_BAR; PG8_SCHED;
            PG8_LDB(B1, 1, 1); PG8_STAGE(PG8_SB(1, 0), b3, voffB);
            PG8_BAR; PG8_WAIT_L(0); PG8_MMA(0, 1, At, B1); PG8_BAR;
            PG8_LDA(At, 1, 1); PG8_STAGE(PG8_SA(1, 0), a3, voffA);
            PG8_BAR; PG8_WAIT_L(0); PG8_MMA(1, 0, At, B0); PG8_BAR; PG8_SCHED;
            PG8_STAGE(PG8_SB(1, 1), b3 + hstep, voffB);
            PG8_WAIT_V(6); PG8_BAR; PG8_MMA(1, 1, At, B1); PG8_BAR;
            }
        }
        if constexpr (ALIGN_EPI) { if (wr == 0) PG8_BAR; }
        if constexpr (!Epi::AFTER_DRAIN) { E(acc, cur, wr, wc, fr, fq); S.done(cur); }
        if (!has_next) break;
#pragma unroll
        for (int a = 0; a < 2; ++a)
#pragma unroll
            for (int b = 0; b < 2; ++b)
#pragma unroll
                for (int m = 0; m < 4; ++m)
#pragma unroll
                    for (int n = 0; n < 2; ++n) acc[a][b][m][n] = (f32x4){0.f, 0.f, 0.f, 0.f};
        cur = nxt; cA = nA; cB = nB; ++ui;
        if constexpr (ALIGN_EPI) { if (wr == 1) PG8_BAR; }
    }
    PG8_WAIT_V(0);
    if constexpr (!ALIGN_EPI) { if (wr == 0) PG8_BAR; }
    PG8_BAR;
    if constexpr (Epi::AFTER_DRAIN) { E.fused(acc, cur, wr, wc, fr, fq, lds, wid, lane); S.done(cur); }
#undef PG8_SA
#undef PG8_SB
#undef PG8_STAGE
#undef PG8_LDA
#undef PG8_LDB
#undef PG8_MMA
#undef PG8_WAIT_V
#undef PG8_WAIT_L
#undef PG8_BAR
#undef PG8_SCHED
}
}

namespace pg8 {
typedef unsigned u32x2 __attribute__((ext_vector_type(2)));
struct EpiIn {
    static constexpr bool PERM = false, AFTER_DRAIN = false;
    bf16_t* Z; bf16_t* QNR; float* out; const float* rope; const float* acmp; float* poolp;
    __device__ __forceinline__ void operator()(const f32x4 (&acc)[2][2][4][2], const Unit& u, int wr, int wc, int fr, int fq) const {
        const int pn = u.pn;
        const bool is_q = (pn >= 8 && pn < 12), is_kv = (pn >= 16 && pn < 22);
        const bool do_rope = (wc == 0) && (is_q || pn == 18 || pn == 20);
        const bool do_z = !(pn == 16 || pn == 17);
#pragma unroll
        for (int ai = 0; ai < 2; ++ai)
#pragma unroll
            for (int m = 0; m < 4; ++m) {
                const int row = u.pm * BM + ai * HALF + wr * 64 + m * 16 + fr;
                if (row >= MALL) continue;
                const int posidx = row < MP ? (row & (PT - 1)) : (PT + ((row - MP) & 3));
                f32x4 cs4 = (f32x4){1.f, 1.f, 1.f, 1.f}, sn4 = (f32x4){0.f, 0.f, 0.f, 0.f};
                if (do_rope) { cs4 = *(const f32x4*)(rope + posidx * 32 + 4 * fq); sn4 = *(const f32x4*)(rope + posidx * 32 + 16 + 4 * fq); }
#pragma unroll
                for (int bj = 0; bj < 2; ++bj) {
                    f32x4 v0 = acc[ai][bj][m][0], v1 = acc[ai][bj][m][1];
                    if (do_rope) {
                        if (is_q) {
                            const int head = (pn - 8) * 2 + bj;
                            bf16_t* qp = QNR + ((size_t)row * 8 + head) * 32 + 4 * fq;
                            u32x2 w0; w0.x = cvt_pk_bf16(v0[0], v0[1]); w0.y = cvt_pk_bf16(v0[2], v0[3]); *(u32x2*)qp = w0;
                            u32x2 w1; w1.x = cvt_pk_bf16(v1[0], v1[1]); w1.y = cvt_pk_bf16(v1[2], v1[3]); *(u32x2*)(qp + 16) = w1;
                        }
                        const f32x4 r0 = v0 * cs4 - v1 * sn4, r1 = v1 * cs4 + v0 * sn4; v0 = r0; v1 = r1;
                    }
                    const int cc = bj * HALF + wc * 32 + 4 * fq;
                    if (do_z) {
                        bf16_t* zp = Z + (size_t)row * ZLD + pn * BM + cc;
                        u32x2 w0; w0.x = cvt_pk_bf16(v0[0], v0[1]); w0.y = cvt_pk_bf16(v0[2], v0[3]); *(u32x2*)zp = w0;
                        u32x2 w1; w1.x = cvt_pk_bf16(v1[0], v1[1]); w1.y = cvt_pk_bf16(v1[2], v1[3]); *(u32x2*)(zp + 16) = w1;
                    }
                    if (is_kv) {
                        const int p = pn - 16; float* op = nullptr;
                        if (row < MP) {
                            if (p < 4) op = out + OFF_KVP + (size_t)row * 1024 + p * 256 + cc;
                            else { const int t = row & (PT - 1); if (t >= PT - 512) op = out + OFF_WINP + ((size_t)((row >> 11) * 512 + t - (PT - 512)) * 2 + (p - 4)) * 256 + cc; }
                        } else {
                            const int rs = row - MP;
                            if (p < 4) op = out + OFF_KVS + (size_t)rs * 1024 + p * 256 + cc;
                            else op = out + OFF_WINS + ((size_t)((rs >> 2) * 512 + 508 + (rs & 3)) * 2 + (p - 4)) * 256 + cc;
                        }
                        if (op) { *(f32x4*)op = v0; *(f32x4*)(op + 16) = v1; }
                    }
                }
            }
        if ((pn == 16 || pn == 17) && u.pm < MP / BM) {
            const int part = pn - 16;
#pragma unroll
            for (int ai = 0; ai < 2; ++ai)
#pragma unroll
                for (int bj = 0; bj < 2; ++bj)
#pragma unroll
                    for (int n = 0; n < 2; ++n) {
                        const int d = wc * 32 + n * 16 + 4 * fq;
                        f32x4 s = (f32x4){0.f, 0.f, 0.f, 0.f};
#pragma unroll
                        for (int m = 0; m < 4; ++m) { const f32x4 a = *(const f32x4*)(acmp + ((size_t)part * 64 + m * 16 + fr) * 128 + d); s += a * acc[ai][bj][m][n]; }
#pragma unroll
                        for (int i = 0; i < 4; ++i) { float x = s[i]; x += __shfl_xor(x, 1); x += __shfl_xor(x, 2); x += __shfl_xor(x, 4); x += __shfl_xor(x, 8); s[i] = x; }
                        if (fr == 0) { const int b = u.pm >> 3, nb = (u.pm & 7) * 4 + ai * 2 + wr;
                            *(f32x4*)(poolp + ((((size_t)b * 32 + nb) * 2 + part) * 2 + bj) * 128 + d) = s; }
                    }
        }
    }
};
struct EpiMem {
    static constexpr bool PERM = false, AFTER_DRAIN = false;
    float* out; bf16_t* MKV;
    __device__ __forceinline__ void operator()(const f32x4 (&acc)[2][2][4][2], const Unit& u, int wr, int wc, int fr, int fq) const {
#pragma unroll
        for (int ai = 0; ai < 2; ++ai)
#pragma unroll
            for (int m = 0; m < 4; ++m) {
                const int row = u.pm * BM + ai * HALF + wr * 64 + m * 16 + fr;
#pragma unroll
                for (int bj = 0; bj < 2; ++bj)
#pragma unroll
                    for (int n = 0; n < 2; ++n) {
                        const int c = u.pn * BM + bj * HALF + wc * 32 + n * 16 + 4 * fq; const f32x4 v = acc[ai][bj][m][n];
                        *(f32x4*)(out + OFF_MEMP + (size_t)row * 1024 + c) = v;
                        u32x2 w; w.x = cvt_pk_bf16(v[0], v[1]); w.y = cvt_pk_bf16(v[2], v[3]); *(u32x2*)(MKV + (size_t)row * 1024 + c) = w;
                    }
            }
    }
};
struct EpiOut {
    static constexpr bool PERM = false, AFTER_DRAIN = false;
    const float* xp; const float* xs; float* out; float* ss;
    __device__ __forceinline__ void operator()(const f32x4 (&acc)[2][2][4][2], const Unit& u, int wr, int wc, int fr, int fq) const {
#pragma unroll
        for (int ai = 0; ai < 2; ++ai)
#pragma unroll
            for (int m = 0; m < 4; ++m) {
                const int row = u.pm * BM + ai * HALF + wr * 64 + m * 16 + fr;
                const bool ok = row < MALL;
                const float* xr = row < MP ? xp + (size_t)row * DM : xs + (size_t)(ok ? row - MP : 0) * DM;
                float* orow = row < MP ? out + OFF_YP + (size_t)row * DM : out + OFF_YS + (size_t)(ok ? row - MP : 0) * DM;
                float q = 0.f;
                if (ok) {
#pragma unroll
                    for (int bj = 0; bj < 2; ++bj)
#pragma unroll
                        for (int n = 0; n < 2; ++n) {
                            const int c = u.pn * BM + bj * HALF + wc * 32 + n * 16 + 4 * fq;
                            const f32x4 v = acc[ai][bj][m][n] + *(const f32x4*)(xr + c);
                            *(f32x4*)(orow + c) = v; q += (v[0] * v[0] + v[1] * v[1]) + (v[2] * v[2] + v[3] * v[3]);
                        }
                }
                q += __shfl_xor(q, 16); q += __shfl_xor(q, 32);
                if (ok && fq == 0) atomicAdd(ss + row, q);
            }
    }
};
}

typedef unsigned short bf16;
typedef unsigned v4u __attribute__((ext_vector_type(4)));
typedef unsigned v2u __attribute__((ext_vector_type(2)));
typedef float f32x4 __attribute__((ext_vector_type(4)));
typedef float f32x2 __attribute__((ext_vector_type(2)));
typedef float f32x16 __attribute__((ext_vector_type(16)));
typedef short bf16x8 __attribute__((ext_vector_type(8)));
typedef short s16x4 __attribute__((ext_vector_type(4)));
#define LDS_WAIT() asm volatile("s_waitcnt lgkmcnt(0)" ::: "memory")
__device__ __forceinline__ unsigned cvtpk(float lo, float hi) { unsigned r; asm volatile("v_cvt_pk_bf16_f32 %0, %1, %2" : "=v"(r) : "v"(lo), "v"(hi)); return r; }
__device__ __forceinline__ float bf2f(bf16 v) { return __uint_as_float(((unsigned)v) << 16); }
__device__ __forceinline__ float wave_sum(float v) {
#pragma unroll
    for (int o = 1; o < 64; o <<= 1) v += __shfl_xor(v, o);
    return v;
}

struct Params {
    const float* x_prompt; const float* x_sample; const float* cache_kv; const float* cache_win; const float* state_conv; const float* cache_mem;
    const int* page_table; const float* mem_prompt; const float* norm_g; const float* w_in; const float* w_conv; const float* a_cmp; const float* w_cmp;
    const float* mem_norm_g; const float* w_mem_kv; const float* w_out; const float* final_g;
    float* out; unsigned char* ws; int ph_lo, ph_hi;
};
struct Frame {
    lbyte* lds; int tid, lane, wave, vcu, G; unsigned char* ws;
#define WSP(T, name, off) __device__ __forceinline__ T* name() const { return (T*)(ws + (off)); }
    WSP(bf16, WinT, WS_WIN) WSP(bf16, WoutT, WS_WOUT) WSP(bf16, WmemT, WS_WMEM) WSP(bf16, HN, WS_HN) WSP(bf16, HM, WS_HM) WSP(bf16, Z, WS_Z) WSP(bf16, MIX, WS_MIX) WSP(bf16, MKV, WS_MKV)
    WSP(bf16, QNR, WS_QNR) WSP(bf16, KCP, WS_KCP) WSP(bf16, VCP, WS_VCP) WSP(bf16, KCS, WS_KCS) WSP(bf16, VCS, WS_VCS)
    WSP(float, POOLP, WS_POOLP) WSP(float, POOLS, WS_POOLS) WSP(float, ROPE, WS_ROPE) WSP(float, SS, WS_CTL + 4096) WSP(unsigned, QUEUE, WS_CTL) WSP(float, TOT, WS_TOT)
#undef WSP
};

template <int MODE  >
__device__ __forceinline__ void p0_transpose_item(const float* W, int K, int N, bf16* WT, LAS float* scr, int nblk, int item, int lane) {
    const int kb = item / nblk, nb = item % nblk, k0 = 64 * kb, n0 = 32 * nb;
    int sc = n0 + (lane & 31);
    if (MODE == 1) { const int zc = sc; sc = zc < ZC_KV ? zc : (zc < ZC_BG ? zc + 24 : (zc < INW ? zc - ZC_BG + 4096 : -1)); }
#pragma unroll 8
    for (int i = 0; i < 32; ++i) { const int kk = 2 * i + (lane >> 5); scr[kk * 33 + (lane & 31)] = sc >= 0 ? W[(size_t)(k0 + kk) * N + sc] : 0.f; }
    LDS_WAIT(); asm volatile("" ::: "memory");
    const int c = lane & 7;
#pragma unroll
    for (int j = 0; j < 4; ++j) { const int n = (lane >> 3) + 8 * j; const LAS float* s = scr + (8 * c) * 33 + n;
        v4u o; o.x = cvtpk(s[0 * 33], s[1 * 33]); o.y = cvtpk(s[2 * 33], s[3 * 33]); o.z = cvtpk(s[4 * 33], s[5 * 33]); o.w = cvtpk(s[6 * 33], s[7 * 33]);
        *(v4u*)(WT + (size_t)(n0 + n) * K + k0 + 8 * c) = o; }
    LDS_WAIT(); asm volatile("" ::: "memory");
}
__device__ __forceinline__ void rms_row_to_bf16(const float* xrow, const float* g, bf16* orow, int lane) {
    const f32x4* xr = (const f32x4*)xrow + lane; const f32x4* gr = (const f32x4*)g + lane;
    f32x4 v[8]; float s = 0.f;
#pragma unroll
    for (int j = 0; j < 8; ++j) { v[j] = xr[64 * j]; s += (v[j].x * v[j].x + v[j].y * v[j].y) + (v[j].z * v[j].z + v[j].w * v[j].w); }
    const float rstd = 1.0f / sqrtf(wave_sum(s) * (1.f / DM) + NORM_EPS);
    v2u* o8 = (v2u*)orow + lane;
#pragma unroll
    for (int j = 0; j < 8; ++j) { const f32x4 gg = gr[64 * j]; v2u w; w.x = cvtpk(v[j].x * rstd * gg.x, v[j].y * rstd * gg.y); w.y = cvtpk(v[j].z * rstd * gg.z, v[j].w * rstd * gg.w); o8[64 * j] = w; }
}
__device__ __forceinline__ void p0_prologue(const Params& P, Frame& F) {
    {
        LAS f32x4* red = (LAS f32x4*)F.lds;
        const int c4 = F.tid & 127, rg = F.tid >> 7;
        const int part = c4 >> 6, d = (c4 * 4) & 127;
        for (int it = F.vcu; it < SBATCH * 256; it += F.G) {
            const int b = it >> 8, n = it & 255;
            const int page = P.page_table[b * NPAGES + (n >> 1)];
            const float* base = P.cache_kv + ((size_t)page * 128 + (n & 1) * 64) * 1024 + c4 * 4;
            f32x4 acc = (f32x4){0.f, 0.f, 0.f, 0.f};
#pragma unroll 16
            for (int i = 0; i < 16; ++i) { const int j = rg + 4 * i; const f32x4 x = *(const f32x4*)(base + (size_t)j * 1024); const f32x4 a = *(const f32x4*)(P.a_cmp + ((size_t)part * 64 + j) * 128 + d); acc += a * x; }
            red[rg * 128 + c4] = acc;
            __syncthreads();
            if (F.tid < 128) { const f32x4 s = (red[c4] + red[128 + c4]) + (red[256 + c4] + red[384 + c4]); *(f32x4*)(F.POOLS() + (size_t)it * 512 + c4 * 4) = s; }
            __syncthreads();
        }
    }
    {
        LAS float* scr = (LAS float*)(F.lds + F.wave * 16384);
        const int gw = F.vcu * NWAVES + F.wave, NGW = F.G * NWAVES;
        constexpr int I_IN = (DM / 64) * (ZLD / 32), I_OUT = (DM / 64) * (DM / 32), I_MEM = (DM / 64) * (1024 / 32);
        for (int it = gw; it < I_IN + I_OUT + I_MEM; it += NGW) {
            int r = it;
            if (r < I_IN) { p0_transpose_item<1>(P.w_in, DM, INW, F.WinT(), scr, ZLD / 32, r, F.lane); continue; } r -= I_IN;
            if (r < I_OUT) { p0_transpose_item<0>(P.w_out, DM, DM, F.WoutT(), scr, DM / 32, r, F.lane); continue; } r -= I_OUT;
            p0_transpose_item<0>(P.w_mem_kv, DM, 1024, F.WmemT(), scr, 1024 / 32, r, F.lane);
        }
        for (int m = gw; m < MPAD + 1024; m += NGW) {
            if (m < MP) rms_row_to_bf16(P.x_prompt + (size_t)m * DM, P.norm_g, F.HN() + (size_t)m * DM, F.lane);
            else if (m < MALL) rms_row_to_bf16(P.x_sample + (size_t)(m - MP) * DM, P.norm_g, F.HN() + (size_t)m * DM, F.lane);
            else if (m < MPAD) { v4u z = (v4u){0u, 0u, 0u, 0u}; v4u* o = (v4u*)(F.HN() + (size_t)m * DM) + F.lane;
#pragma unroll
                for (int j = 0; j < 4; ++j) o[64 * j] = z; }
            else rms_row_to_bf16(P.mem_prompt + (size_t)(m - MPAD) * DM, P.mem_norm_g, F.HM() + (size_t)(m - MPAD) * DM, F.lane);
        }
    }
    {
        const int gt = F.vcu * NTHREADS + F.tid, NGT = F.G * NTHREADS;
        for (int i = gt; i < 2052 * 16; i += NGT) {
            const int pi = i >> 4, k = i & 15; const float pos = (float)(pi < PT ? pi : PAST + (pi - PT));
            const float fr = powf(500000.0f, -(float)k * (2.0f / 32.0f)); const float ang = pos * fr;
            float sn, cs; sincosf(ang, &sn, &cs); F.ROPE()[pi * 32 + k] = cs; F.ROPE()[pi * 32 + 16 + k] = sn;
        }
        constexpr int NCP = SBATCH * 508 * 128;
        for (int i = gt; i < NCP; i += NGT) { const int b = i / (508 * 128), r = i - b * (508 * 128);
            ((f32x4*)(P.out + OFF_WINS + (size_t)b * 512 * 512))[r] = ((const f32x4*)(P.cache_win + (size_t)b * 512 * 512 + 4 * 512))[r]; }
    }
}

__device__ __forceinline__ void p2_cmp_finalize(const Params& P, Frame& F) {
    const int gw = F.vcu * NWAVES + F.wave, NGW = F.G * NWAVES;
    constexpr int NP = PB * 32 * 4, NS = SBATCH * 256 * 4;
    for (int it = gw; it < NP + NS; it += NGW) {
        const float* src; bf16* dst; int part;
        if (it < NP) { const int g = it & 1; part = (it >> 1) & 1; const int n = (it >> 2) & 31, b = it >> 7; src = F.POOLP() + (size_t)it * 128; dst = (part ? F.VCP() : F.KCP()) + ((size_t)(b * 2 + g) * 64 + n) * 128; }
        else { const int i2 = it - NP; const int g = i2 & 1; part = (i2 >> 1) & 1; const int n = (i2 >> 2) & 255, b = i2 >> 10; src = F.POOLS() + (size_t)i2 * 128; dst = (part ? F.VCS() : F.KCS()) + ((size_t)(b * 2 + g) * 256 + n) * 128; }
        const float p0 = src[F.lane], p1 = src[64 + F.lane];
        const float* w = P.w_cmp + (size_t)part * 128 * 128 + 2 * F.lane;
        float a0 = 0.f, a1 = 0.f;
#pragma unroll 8
        for (int d = 0; d < 64; ++d) { const float pd = __shfl(p0, d); const f32x2 ww = *(const f32x2*)(w + (size_t)d * 128); a0 += pd * ww.x; a1 += pd * ww.y; }
#pragma unroll 8
        for (int d = 0; d < 64; ++d) { const float pd = __shfl(p1, d); const f32x2 ww = *(const f32x2*)(w + (size_t)(64 + d) * 128); a0 += pd * ww.x; a1 += pd * ww.y; }
        *(unsigned*)(dst + 2 * F.lane) = cvtpk(a0, a1);
    }
    const int gt = F.vcu * NTHREADS + F.tid, NGT = F.G * NTHREADS;
    for (int i = gt; i < 2 * PB * 2 * 32 * 16; i += NGT) {
        const int kv = i / (PB * 2 * 32 * 16), r = i % (PB * 2 * 32 * 16), bg = r / 512, w = r % 512;
        ((v4u*)((kv ? F.VCP() : F.KCP()) + ((size_t)bg * 64 + 32) * 128))[w] = (v4u){0u, 0u, 0u, 0u};
    }
}

namespace att {
constexpr float SCALE = 0.08838834764831845f, C2 = 1.4426950408889634f * SCALE, THR = 8.f;
constexpr int SHM_T = 16384;
constexpr int L_MISC = 131072, L_WSF = L_MISC, L_LIST = L_WSF + 4096, L_RMASK = L_LIST + 768, L_ML = L_RMASK + 1056, L_IMP = L_ML + 1024, L_SD = L_IMP + 4096, L_CTRL = L_SD + 16384, L_END = L_CTRL + 64;
static_assert(L_END <= LDS_BYTES, "attention LDS map");
constexpr int SNT = 2;
constexpr int U_SNSA = SBATCH * 2 * (STOK / SNT), U_PNSA = PB * 2 * (PT / 32), U_PMEM = PB * 4 * (PT / 128), U_SMEM = SBATCH * 4, U_CONV = (MALL + 31) / 32;
constexpr int U0_PNSA = U_SNSA, U0_PMEM = U0_PNSA + U_PNSA, U0_SMEM = U0_PMEM + U_PMEM, U0_CONV = U0_SMEM + U_SMEM, U_TOTAL = U0_CONV + U_CONV;

#define KSWZ(row, colB) ((row) * 256 + ((colB) ^ (((row) & 7) << 4)))
#define SBAR() __builtin_amdgcn_sched_barrier(0)
__device__ __forceinline__ int v_st(int k, int c) { const int kk = (k & ~0xC) | ((k & 4) << 1) | ((k & 8) >> 1); return ((kk >> 3) * 4 + (c >> 5)) * 512 + ((kk & 7) * 32 + (c & 31)) * 2; }
__device__ __forceinline__ int v_rd_base(int lane) { return ((lane & 3) << 3) | (((lane >> 2) & 3) << 6) | (((lane >> 4) & 1) << 5) | (((lane >> 5) & 1) << 8); }
constexpr int v_rd_off(int d0, int ks, int half) { return d0 * 512 + ks * 4096 + half * 2048; }
__device__ __forceinline__ int crow(int r, int hi) { return (r & 3) + 8 * (r >> 2) + 4 * hi; }
__device__ __forceinline__ bf16x8 pack8(f32x4 a, f32x4 b) { v4u w = {cvtpk(a[0], a[1]), cvtpk(a[2], a[3]), cvtpk(b[0], b[1]), cvtpk(b[2], b[3])}; return __builtin_bit_cast(bf16x8, w); }

__device__ __forceinline__ void mask_tile(f32x16& p0, f32x16& p1, bool rowok, int pos, int kpos0, int kstride, unsigned W, int hi) {
    const float NEG = -__builtin_inff();
    const int dq = pos - kpos0 - 4 * hi * kstride;
#pragma unroll
    for (int r = 0; r < 16; ++r) {
        const int c = (r & 3) + 8 * (r >> 2);
        if (!(rowok && (unsigned)(dq - c * kstride) < W)) p0[r] = NEG;
        if (!(rowok && (unsigned)(dq - (c + 32) * kstride) < W)) p1[r] = NEG;
    }
}
__device__ __forceinline__ void partialSM(f32x16& p0, f32x16& p1, float& m_reg, float& mn, float& alpha) {
    float pmax = p0[0];
#pragma unroll
    for (int r = 1; r < 16; ++r) pmax = fmaxf(pmax, p0[r]);
#pragma unroll
    for (int r = 0; r < 16; ++r) pmax = fmaxf(pmax, p1[r]);
    { auto rr = __builtin_amdgcn_permlane32_swap(__float_as_uint(pmax), __float_as_uint(pmax), false, false);
      pmax = fmaxf(__uint_as_float(rr[0]), __uint_as_float(rr[1])); }
    if (__builtin_expect(__all((pmax - m_reg) * SCALE <= THR), 1)) { mn = m_reg; alpha = 1.f; }
    else { mn = fmaxf(m_reg, pmax); alpha = __builtin_amdgcn_exp2f((m_reg - mn) * C2); m_reg = mn; }
    const float mnL = -mn * C2;
#pragma unroll
    for (int r = 0; r < 16; ++r) p0[r] = fmaf(p0[r], C2, mnL);
#pragma unroll
    for (int r = 0; r < 16; ++r) p1[r] = fmaf(p1[r], C2, mnL);
#pragma unroll
    for (int r = 0; r < 16; ++r) p0[r] = __builtin_amdgcn_exp2f(p0[r]);
}
__device__ __forceinline__ void finishSM(f32x16& p0, f32x16& p1, float alpha, float& l_reg, bf16x8& pa0, bf16x8& pa1, bf16x8& pa2, bf16x8& pa3) {
#pragma unroll
    for (int r = 0; r < 16; ++r) p1[r] = __builtin_amdgcn_exp2f(p1[r]);
    float ps = 0;
#pragma unroll
    for (int r = 0; r < 16; ++r) ps += p0[r];
#pragma unroll
    for (int r = 0; r < 16; ++r) ps += p1[r];
    { auto rr = __builtin_amdgcn_permlane32_swap(__float_as_uint(ps), __float_as_uint(ps), false, false);
      ps = __uint_as_float(rr[0]) + __uint_as_float(rr[1]); }
    l_reg = l_reg * alpha + ps;
#define PK4(P, B_, OUT) do { unsigned a0 = cvtpk(P[B_+0], P[B_+1]), a1 = cvtpk(P[B_+2], P[B_+3]);                          \
        unsigned b0 = cvtpk(P[B_+4], P[B_+5]), b1 = cvtpk(P[B_+6], P[B_+7]);                                             \
        auto r0 = __builtin_amdgcn_permlane32_swap(a0, b0, false, false); auto r1 = __builtin_amdgcn_permlane32_swap(a1, b1, false, false); \
        v4u w = {r0[0], r1[0], r0[1], r1[1]}; OUT = __builtin_bit_cast(bf16x8, w); } while (0)
    PK4(p0, 0, pa0); PK4(p0, 8, pa1); PK4(p1, 0, pa2); PK4(p1, 8, pa3);
#undef PK4
}
__device__ __forceinline__ void qkt(f32x16& p0, f32x16& p1, const lbyte* Kt, int r32, int hi, const bf16x8* qr) {
    p0 = f32x16{}; p1 = f32x16{};
    const lbyte* kb[4];
#pragma unroll
    for (int dd = 0; dd < 4; ++dd) kb[dd] = Kt + KSWZ(r32, (dd * 16 + hi * 8) * 2);
#pragma unroll
    for (int d0 = 0; d0 < 8; ++d0) { const lbyte* a = kb[d0 & 3] + (d0 >> 2) * 128;
        const bf16x8 b0 = *(const LAS bf16x8*)(a);
        const bf16x8 b1 = *(const LAS bf16x8*)(a + 32 * 256);
        p0 = __builtin_amdgcn_mfma_f32_32x32x16_bf16(b0, qr[d0], p0, 0, 0, 0);
        p1 = __builtin_amdgcn_mfma_f32_32x32x16_bf16(b1, qr[d0], p1, 0, 0, 0); }
}
__device__ __forceinline__ void pv_tile(f32x16* o, int vb, bf16x8 pa0, bf16x8 pa1, bf16x8 pa2, bf16x8 pa3) {
#define TRRD(dst, off) asm volatile("ds_read_b64_tr_b16 %0, %1 offset:%2" : "=&v"(dst) : "v"(vb), "i"(off) : "memory")
#define PV_D0(d0) do { s16x4 l0, l1, l2, l3, h0, h1, h2, h3; constexpr int b_ = v_rd_off(d0, 0, 0); \
        TRRD(l0, b_); TRRD(h0, b_ + 2048); TRRD(l1, b_ + 4096); TRRD(h1, b_ + 6144); TRRD(l2, b_ + 8192); TRRD(h2, b_ + 10240); TRRD(l3, b_ + 12288); TRRD(h3, b_ + 14336); \
        asm volatile("s_waitcnt lgkmcnt(0)" ::: "memory"); SBAR(); \
        o[d0] = __builtin_amdgcn_mfma_f32_32x32x16_bf16(pa0, (bf16x8){l0[0], l0[1], l0[2], l0[3], h0[0], h0[1], h0[2], h0[3]}, o[d0], 0, 0, 0);   \
        o[d0] = __builtin_amdgcn_mfma_f32_32x32x16_bf16(pa1, (bf16x8){l1[0], l1[1], l1[2], l1[3], h1[0], h1[1], h1[2], h1[3]}, o[d0], 0, 0, 0);   \
        o[d0] = __builtin_amdgcn_mfma_f32_32x32x16_bf16(pa2, (bf16x8){l2[0], l2[1], l2[2], l2[3], h2[0], h2[1], h2[2], h2[3]}, o[d0], 0, 0, 0);   \
        o[d0] = __builtin_amdgcn_mfma_f32_32x32x16_bf16(pa3, (bf16x8){l3[0], l3[1], l3[2], l3[3], h3[0], h3[1], h3[2], h3[3]}, o[d0], 0, 0, 0); } while (0)
    PV_D0(0); PV_D0(1); PV_D0(2); PV_D0(3);
#undef PV_D0
#undef TRRD
}

struct TileSrc { const char* kp; const char* vp; int strideB; int f32; int kpos0; int nvalid; unsigned rowmask; };

__device__ __forceinline__ TileSrc tile_src(const Params& P, const Frame& F, int sample, int bk, int b, int gh, int j) {
    TileSrc s; s.nvalid = 64; s.f32 = 0; s.rowmask = 0xffffffffu;
    if (!sample) {
        if (bk == 0) { const size_t o = ((size_t)(b * 2 + gh) * 64) * 128 * 2; s.kp = (const char*)F.KCP() + o; s.vp = (const char*)F.VCP() + o; s.strideB = 256; s.kpos0 = 63; }
        else if (bk == 3) { const size_t o = (((size_t)b * 256 + j * 64) * 1024 + gh * 128) * 2; s.kp = (const char*)F.MKV() + o; s.vp = s.kp + 512 * 2; s.strideB = 2048; s.kpos0 = 0; }
        else { const int part = bk == 1 ? 2 : 4; const size_t o = (((size_t)b * PT + j * 64) * ZLD + ZC_KV + part * 256 + gh * 128) * 2;
               s.kp = (const char*)F.Z() + o; s.vp = s.kp + 256 * 2; s.strideB = ZLD * 2; s.kpos0 = j * 64; }
    } else {
        if (bk == 0) { const size_t o = (((size_t)(b * 2 + gh) * 256 + j * 64) * 128) * 2; s.kp = (const char*)F.KCS() + o; s.vp = (const char*)F.VCS() + o; s.strideB = 256; s.kpos0 = j * 4096 + 63; }
        else if (bk == 3) { const size_t o = ((((size_t)b * 256 + j * 64) * 2) * 4 + gh) * 128 * 4; s.kp = (const char*)P.cache_mem + o; s.vp = s.kp + 512 * 4; s.strideB = 4096; s.f32 = 1; s.kpos0 = 0; }
        else if (bk == 1 && j < 256) { const int page = P.page_table[b * NPAGES + (j >> 1)];
               const size_t o = (((size_t)page * 128 + (j & 1) * 64) * 1024 + 2 * 256 + gh * 128) * 4; s.kp = (const char*)P.cache_kv + o; s.vp = s.kp + 256 * 4; s.strideB = 4096; s.f32 = 1; s.kpos0 = j * 64; }
        else if (bk == 2 && j < 8) { const size_t o = ((((size_t)b * 512 + j * 64) * 2) * 2 + gh) * 128 * 4; s.kp = (const char*)P.cache_win + o; s.vp = s.kp + 256 * 4; s.strideB = 2048; s.f32 = 1; s.kpos0 = (PAST - 512) + j * 64; }
        else { const int part = bk == 1 ? 2 : 4; const size_t o = (((size_t)MP + b * 4) * ZLD + ZC_KV + part * 256 + gh * 128) * 2;
               s.kp = (const char*)F.Z() + o; s.vp = s.kp + 256 * 2; s.strideB = ZLD * 2; s.kpos0 = PAST; s.nvalid = 4; }
    }
    return s;
}

__device__ __forceinline__ void attn_unit(const Params& P, const Frame& F0, int kind, int b, int gh, int t0, int nt) {
    Frame F = F0; asm volatile("" : "+s"(F.ws));
    int tid = F.wave * 64 + (int)__builtin_amdgcn_mbcnt_hi(~0u, __builtin_amdgcn_mbcnt_lo(~0u, 0u)); asm volatile("" : "+v"(tid));
    const int lane = tid & 63, wid = F.wave, r32 = lane & 31, hi = lane >> 5, w4 = wid & 3, grp = wid >> 2;
    const bool nsa = kind < 2; const int sample = kind & 1;
    lbyte* const lds = F.lds;
    LAS float* const wsf = (LAS float*)(lds + L_WSF) + wid * 128;
    LAS int* const LIST = (LAS int*)(lds + L_LIST);
    LAS unsigned* const RMASK = (LAS unsigned*)(lds + L_RMASK);
    LAS float* const ML = (LAS float*)(lds + L_ML);
    LAS float* const IMP = (LAS float*)(lds + L_IMP);
    LAS float* const SD = (LAS float*)(lds + L_SD);
    LAS int* const CTRL = (LAS int*)(lds + L_CTRL);
    LAS float* const XCH = (LAS float*)lds;

    const int tokidx = (nsa ? 0 : w4 * 32) + r32;
    const bool valid = tokidx < nt;
    const int rowbase = sample ? MP + b * 4 + t0 : b * PT + t0;
    const int grow = rowbase + (valid ? tokidx : 0);
    const int pos = (sample ? PAST + t0 : t0) + tokidx;
    const int head = nsa ? gh * 4 + w4 : gh;
    const int qcol = nsa ? ZC_Q + head * 128 : ZC_MQ + head * 128;
    const int g2col = nsa ? ZC_NG + head * 128 : ZC_MG + head * 128;
    const int mixcol = nsa ? 512 + head * 128 : 1536 + head * 128;
    const int cur = sample ? 256 : (t0 >> 6);
    const unsigned vmask = nt >= 32 ? 0xffffffffu : ((1u << nt) - 1u);

    bf16x8 qr[8];
    { const bf16* qp = F.Z() + (size_t)grow * ZLD + qcol + hi * 8;
#pragma unroll
      for (int d0 = 0; d0 < 8; ++d0) qr[d0] = *(const bf16x8*)(qp + d0 * 16); }
    float* const TOT = F.TOT() + ((size_t)blockIdx.x * 4 + w4) * 4096 + lane;

    const int tg = tid & 255, sr = tg >> 4, sc = (tg & 15) * 8;
    lbyte* const Kg = lds + grp * (4 * SHM_T);
    const int vrd = v_rd_base(lane);
    const int dk_row = lane >> 4, dk_c0 = (lane & 15) ^ (lane >> 4);
    const int dv_kk = (lane & 31) >> 2, dv_c = (lane & 3) * 8;

    const int nbr = nsa ? 3 : 1;
    for (int br = 0; br < nbr; ++br) {
        const int bk = nsa ? br : 3;
        int ntiles, jlo = 0, listmode = 0, kstride = 1; unsigned W = 0x7fffffffu;
        if (bk == 0) { ntiles = sample ? 4 : 1; kstride = 64; }
        else if (bk == 1) { ntiles = CTRL[1]; listmode = 1; }
        else if (bk == 2) { W = 512u; if (sample) { ntiles = 9; } else { const int lo = t0 - 511; jlo = lo > 0 ? (lo >> 6) : 0; ntiles = ((t0 + nt - 1) >> 6) - jlo + 1; } }
        else { ntiles = 4; kstride = 0; }
        ntiles = __builtin_amdgcn_readfirstlane(ntiles);
        if (nsa && bk <= 1) {
            if (bk == 0) { const bf16* qp = F.QNR() + ((size_t)grow * 8 + head) * 32 + hi * 8; qr[0] = *(const bf16x8*)qp; qr[1] = *(const bf16x8*)(qp + 16); }
            else { const bf16* qp = F.Z() + (size_t)grow * ZLD + qcol + hi * 8; qr[0] = *(const bf16x8*)qp; qr[1] = *(const bf16x8*)(qp + 16); }
        }
        const float gate = nsa ? 1.0f / (1.0f + __expf(-bf2f(F.Z()[(size_t)grow * ZLD + ZC_BG + head * 3 + br]))) : 1.0f;
        const bool dump = nsa && bk == 0;
        const int dumpNK = sample ? 256 : 32, dumpNT = sample ? nt : 32;

        float m_reg = -1e30f, l_reg = 0.f; f32x16 o[4];
#pragma unroll
        for (int d0 = 0; d0 < 4; ++d0) o[d0] = f32x16{};

        const int nsteps = (ntiles + 1) >> 1;
#define GET_ENTRY(e, J, RM) do { if (listmode) { J = __builtin_amdgcn_readfirstlane(LIST[2 * (e)]); RM = (unsigned)__builtin_amdgcn_readfirstlane(LIST[2 * (e) + 1]); } else { J = jlo + (e); RM = 0xffffffffu; } } while (0)
#define STAGE_DMA(S_, bf) do { lbyte* Kt_ = Kg + (bf) * (2 * SHM_T); lbyte* Vt_ = Kt_ + SHM_T; _Pragma("unroll") for (int i_ = 0; i_ < 4; ++i_) { const int q_ = w4 * 4 + i_; \
            __builtin_amdgcn_global_load_lds((const unsigned*)((S_).kp + (size_t)(q_ * 4 + dk_row) * (S_).strideB + ((dk_c0 ^ ((i_ & 1) << 2)) * 16)), (LAS unsigned*)(Kt_ + q_ * 1024), 16, 0, 0); \
            const int st_ = 2 * q_ + (lane >> 5); const int kk_ = (st_ >> 2) * 8 + dv_kk; const int k_ = (kk_ & ~0xC) | ((kk_ & 4) << 1) | ((kk_ & 8) >> 1); \
            __builtin_amdgcn_global_load_lds((const unsigned*)((S_).vp + (size_t)k_ * (S_).strideB + ((st_ & 3) * 32 + dv_c) * 2), (LAS unsigned*)(Vt_ + q_ * 1024), 16, 0, 0); } } while (0)
#define STAGE_SYNC(S_, bf) do { lbyte* Kt_ = Kg + (bf) * (2 * SHM_T); lbyte* Vt_ = Kt_ + SHM_T; _Pragma("unroll") for (int i_ = 0; i_ < 4; ++i_) { const int row_ = sr + 16 * i_; \
            bf16x8 k_ = bf16x8{}, v_ = bf16x8{}; \
            if (row_ < (S_).nvalid) { \
                if ((S_).f32) { const float* kq_ = (const float*)((S_).kp + (size_t)row_ * (S_).strideB) + sc; const float* vq_ = (const float*)((S_).vp + (size_t)row_ * (S_).strideB) + sc; \
                    k_ = pack8(*(const f32x4*)kq_, *(const f32x4*)(kq_ + 4)); v_ = pack8(*(const f32x4*)vq_, *(const f32x4*)(vq_ + 4)); } \
                else { k_ = *(const bf16x8*)((S_).kp + (size_t)row_ * (S_).strideB + sc * 2); v_ = *(const bf16x8*)((S_).vp + (size_t)row_ * (S_).strideB + sc * 2); } } \
            *(LAS bf16x8*)(Kt_ + KSWZ(row_, sc * 2)) = k_; *(LAS bf16x8*)(Vt_ + v_st(row_, sc)) = v_; if (i_ & 1) asm volatile("" ::: "memory"); } } while (0)
#define IS_DMA(S_) (!(S_).f32 && (S_).nvalid == 64)
        TileSrc cs; cs.kpos0 = 0; cs.rowmask = 0u;
        if (grp < ntiles) { int j; unsigned rm; GET_ENTRY(grp, j, rm); cs = tile_src(P, F, sample, bk, b, gh, j); cs.rowmask = rm;
            if (IS_DMA(cs)) { STAGE_DMA(cs, 0); } else { STAGE_SYNC(cs, 0); } }
        asm volatile("s_waitcnt vmcnt(0)" ::: "memory");
        __syncthreads();
        for (int s = 0; s < nsteps; ++s) {
            const int e = 2 * s + grp, en = e + 2; const bool hn = en < ntiles;
            TileSrc ns; ns.kpos0 = 0; ns.rowmask = 0u; ns.f32 = 0;
            if (hn) { int j; unsigned rm; GET_ENTRY(en, j, rm); ns = tile_src(P, F, sample, bk, b, gh, j); ns.rowmask = rm; if (IS_DMA(ns)) { STAGE_DMA(ns, (s + 1) & 1); } }
            if (e < ntiles) {
                const lbyte* Kt = Kg + (s & 1) * (2 * SHM_T);
                f32x16 p0, p1; float mn, alpha; bf16x8 pa0, pa1, pa2, pa3;
                qkt(p0, p1, Kt, r32, hi, qr);
                mask_tile(p0, p1, valid && ((cs.rowmask >> (r32 & 31)) & 1u), pos, cs.kpos0, kstride, W, hi);
                if (dump && r32 < dumpNT) {
                    const int key0 = (sample ? ((cs.kpos0 - 63) >> 6) : 0);
#pragma unroll
                    for (int r = 0; r < 16; ++r) { const int kk = key0 + crow(r, hi);
                        if (kk < dumpNK) SD[(w4 * dumpNT + r32) * dumpNK + kk] = p0[r];
                        if (kk + 32 < dumpNK) SD[(w4 * dumpNT + r32) * dumpNK + kk + 32] = p1[r]; }
                }
                partialSM(p0, p1, m_reg, mn, alpha);
                finishSM(p0, p1, alpha, l_reg, pa0, pa1, pa2, pa3);
                if (__any(alpha < 1.f)) { if (hi == 0) wsf[r32] = alpha; LDS_WAIT();
#pragma unroll
                    for (int r = 0; r < 16; ++r) { const float a = wsf[crow(r, hi)];
#pragma unroll
                        for (int d0 = 0; d0 < 4; ++d0) o[d0][r] *= a; } }
                pv_tile(o, (int)(unsigned)(uintptr_t)(Kt + SHM_T) + vrd, pa0, pa1, pa2, pa3);
            }
            if (hn && !IS_DMA(ns)) { STAGE_SYNC(ns, (s + 1) & 1); }
            cs = ns;
            asm volatile("s_waitcnt vmcnt(0)" ::: "memory");
            __syncthreads();
        }
#undef GET_ENTRY
#undef STAGE_DMA
#undef STAGE_SYNC
#undef IS_DMA
        if (grp == 1) {
#pragma unroll
            for (int d0 = 0; d0 < 4; ++d0)
#pragma unroll
                for (int r = 0; r < 16; ++r) XCH[(w4 * 66 + d0 * 16 + r) * 64 + lane] = o[d0][r];
            XCH[(w4 * 66 + 64) * 64 + lane] = m_reg; XCH[(w4 * 66 + 65) * 64 + lane] = l_reg;
        }
        __syncthreads();
        if (grp == 0) {
            const float mB = XCH[(w4 * 66 + 64) * 64 + lane], lB = XCH[(w4 * 66 + 65) * 64 + lane];
            const float mN = fmaxf(m_reg, mB);
            const float fA = __builtin_amdgcn_exp2f((m_reg - mN) * C2), fB = __builtin_amdgcn_exp2f((mB - mN) * C2);
            const float l = l_reg * fA + lB * fB;
            const float inv = l > 0.f ? 1.0f / l : 0.f;
            if (hi == 0) { wsf[r32] = gate * fA * inv; wsf[32 + r32] = gate * fB * inv; if (dump) { ML[(w4 * 32 + r32) * 2] = mN; ML[(w4 * 32 + r32) * 2 + 1] = inv; } }
            LDS_WAIT();
            float* tp = TOT;
#pragma unroll
            for (int r = 0; r < 16; ++r) { const float ca = wsf[crow(r, hi)], cb = wsf[32 + crow(r, hi)];
#pragma unroll
                for (int d0 = 0; d0 < 4; ++d0) { float v = ca * o[d0][r] + cb * XCH[(w4 * 66 + d0 * 16 + r) * 64 + lane];
                    if (br > 0) v += tp[d0 * 64];
                    tp[d0 * 64] = v; }
                tp += 256; asm volatile("" : "+v"(tp) :: "memory"); }
        }
        __syncthreads();
        if (dump) {
            const int total = dumpNT * dumpNK;
            for (int idx = tid; idx < total; idx += NTHREADS) { const int t = idx / dumpNK, j = idx - t * dumpNK; float s = 0.f;
#pragma unroll
                for (int w = 0; w < 4; ++w) { const float sc_ = SD[(w * dumpNT + t) * dumpNK + j]; s += __builtin_amdgcn_exp2f((sc_ - ML[(w * 32 + t) * 2]) * C2) * ML[(w * 32 + t) * 2 + 1]; }
                IMP[idx] = s; }
            for (int j = tid; j <= cur; j += NTHREADS) RMASK[j] = (j == 0 || j == cur || j == cur - 1) ? vmask : 0u;
            __syncthreads();
            const int nforced = cur == 0 ? 1 : (cur == 1 ? 2 : 3), ksel = 16 - nforced;
            for (int idx = tid; idx < total; idx += NTHREADS) { const int t = idx / dumpNK, j = idx - t * dumpNK;
                if (t < nt && j >= 1 && j <= cur - 2) { const float v = IMP[idx]; int rank = 0;
                    for (int i = 1; i <= cur - 2; ++i) { const float x = IMP[t * dumpNK + i]; rank += (x > v || (x == v && i < j)) ? 1 : 0; }
                    if (rank < ksel) __hip_atomic_fetch_or(&RMASK[j], 1u << t, __ATOMIC_RELAXED, __HIP_MEMORY_SCOPE_WORKGROUP); } }
            __syncthreads();
            if (wid == 0) { int n = 0;
                for (int base = 0; base <= cur; base += 64) { const int j = base + lane; const unsigned rm = j <= cur ? RMASK[j] : 0u; const bool has = rm != 0u;
                    const unsigned long long bal = __ballot(has);
                    if (has) { const int ix = n + __popcll(bal & ((1ull << lane) - 1ull)); LIST[2 * ix] = j; LIST[2 * ix + 1] = (int)rm; }
                    n += __popcll(bal); }
                if (lane == 0) CTRL[1] = n; }
            __syncthreads();
        }
    }
    if (grp == 0) {
        const float* tp = TOT;
#pragma unroll
        for (int r = 0; r < 16; ++r) { const int ti = (nsa ? 0 : w4 * 32) + crow(r, hi);
            if (ti < nt) { const size_t rowg = (size_t)(rowbase + ti);
#pragma unroll
                for (int d0 = 0; d0 < 4; ++d0) { const int c = d0 * 32 + r32; const float gt = bf2f(F.Z()[rowg * ZLD + g2col + c]);
                    const float v = tp[d0 * 64] * (gt / (1.0f + __expf(-gt)));
                    const float vn = __shfl_xor(v, 1);
                    if ((r32 & 1) == 0) *(unsigned*)(F.MIX() + rowg * DM + mixcol + c) = cvtpk(v, vn); } }
            tp += 256; asm volatile("" : "+v"(tp) :: "memory"); }
    }
}
#undef KSWZ
#undef SBAR

__device__ __forceinline__ void conv_unit(const Params& P, const Frame& F0, int cu) {
    Frame F = F0; asm volatile("" : "+s"(F.ws));
    int c = F.wave * 64 + (int)__builtin_amdgcn_mbcnt_hi(~0u, __builtin_amdgcn_mbcnt_lo(~0u, 0u)); asm volatile("" : "+v"(c));
    const int r0 = cu * 32;
    const float w0 = P.w_conv[c], w1 = P.w_conv[512 + c], w2 = P.w_conv[1024 + c];
    float um2 = 0.f, um1 = 0.f;
    if (r0 < MP) { const int t0 = r0 & (PT - 1);
        if (t0 > 0) { const bf16* z2 = F.Z() + (size_t)(r0 - 2) * ZLD; const bf16* z1 = F.Z() + (size_t)(r0 - 1) * ZLD;
            um2 = bf2f(z2[ZC_CC + c]) * bf2f(z2[ZC_CH + c]); um1 = bf2f(z1[ZC_CC + c]) * bf2f(z1[ZC_CH + c]); } }
    for (int i = 0; i < 32; ++i) { const int row = r0 + i; if (row >= MALL) break;
        if (row >= MP && ((row - MP) & 3) == 0) { const int b = (row - MP) >> 2; um2 = P.state_conv[(size_t)b * 1024 + c]; um1 = P.state_conv[(size_t)b * 1024 + 512 + c]; }
        const bf16* z = F.Z() + (size_t)row * ZLD;
        const float u = bf2f(z[ZC_CC + c]) * bf2f(z[ZC_CH + c]);
        const float y = w0 * um2 + w1 * um1 + w2 * u;
        const float gt = bf2f(z[ZC_CG + c]); const float v = (gt / (1.0f + __expf(-gt))) * (bf2f(z[ZC_CB + c]) * y);
        const float vn = __shfl_xor(v, 1);
        if ((c & 1) == 0) *(unsigned*)(F.MIX() + (size_t)row * DM + c) = cvtpk(v, vn);
        if (row < MP) { const int t = row & (PT - 1); if (t >= PT - 2) P.out[OFF_CONVP + ((size_t)(row >> 11) * 2 + (t - (PT - 2))) * 512 + c] = u; }
        else { const int rs = row - MP, t = rs & 3; if (t >= 2) P.out[OFF_CONVS + ((size_t)(rs >> 2) * 2 + (t - 2)) * 512 + c] = u; }
        um2 = um1; um1 = u; }
}

__device__ __forceinline__ void p3_attention(const Params& P, const Frame& F) {
    for (;;) {
        int ctl_off = L_CTRL; asm volatile("" : "+v"(ctl_off));
        LAS int* const CTRL = (LAS int*)(F.lds + ctl_off);
        if (F.wave == 0 && __builtin_amdgcn_mbcnt_hi(~0u, __builtin_amdgcn_mbcnt_lo(~0u, 0u)) == 0u) CTRL[0] = (int)atomicAdd(F.QUEUE(), 1u);
        __syncthreads();
        const int u = __builtin_amdgcn_readfirstlane(CTRL[0]);
        __syncthreads();
        if (u >= U_TOTAL) break;
        if (u >= U0_CONV) { conv_unit(P, F, u - U0_CONV); continue; }
        int kind, b, gh, t0, nt;
        if (u < U0_PNSA) { const int per = STOK / SNT; const int bg = u / per, tt = u % per; kind = 1; b = bg >> 1; gh = bg & 1; t0 = tt * SNT; nt = SNT; }
        else if (u < U0_PMEM) { const int v = u - U0_PNSA; const int qt = 63 - (v >> 3), bg = v & 7; kind = 0; b = bg >> 1; gh = bg & 1; t0 = qt * 32; nt = 32; }
        else if (u < U0_SMEM) { const int v = u - U0_PMEM; const int qt = v >> 4, bh = v & 15; kind = 2; b = bh >> 2; gh = bh & 3; t0 = qt * 128; nt = 128; }
        else { const int v = u - U0_SMEM; kind = 3; b = v >> 2; gh = v & 3; t0 = 0; nt = 4; }
        attn_unit(P, F, kind, b, gh, t0, nt);
    }
}
}

__device__ __forceinline__ void p5_final_norm(const Params& P, Frame& F) {
    const int gw = F.vcu * NWAVES + F.wave, NGW = F.G * NWAVES;
    for (int m = gw; m < MALL; m += NGW) {
        float* row = m < MP ? P.out + OFF_YP + (size_t)m * DM : P.out + OFF_YS + (size_t)(m - MP) * DM;
        const float rstd = 1.0f / sqrtf(F.SS()[m] * (1.f / DM) + NORM_EPS);
        f32x4* xr = (f32x4*)row + F.lane; const f32x4* gr = (const f32x4*)P.final_g + F.lane;
#pragma unroll
        for (int j = 0; j < 8; ++j) { f32x4 v = xr[64 * j]; const f32x4 g = gr[64 * j]; v = v * rstd * g; xr[64 * j] = v; }
    }
}

constexpr int N_PHASES = 6;
__global__ void __launch_bounds__(NTHREADS, 2) fwd_megakernel(Params P) {
    extern __shared__ __attribute__((aligned(16))) unsigned char lds_raw[];
    cg::grid_group grid = cg::this_grid();
    Frame F;
    F.lds = (lbyte*)lds_raw;
    F.tid = threadIdx.x; F.lane = F.tid & 63; F.wave = __builtin_amdgcn_readfirstlane(F.tid >> 6);
    F.G = gridDim.x; { const int bx = blockIdx.x; F.vcu = (F.G % 8 == 0) ? (bx % 8) * (F.G / 8) + bx / 8 : bx; }
    F.ws = P.ws;
    const int lo = P.ph_lo, hi = P.ph_hi;
#ifndef PH_MASK
#define PH_MASK 63
#endif
#define IN(k) (((PH_MASK >> (k)) & 1) && lo <= (k) && (k) < hi)
#define SEAM(k) do { if (IN(k) && IN((k) + 1)) grid.sync(); } while (0)

    if (IN(0)) { p0_prologue(P, F); }
    SEAM(0);
    if (IN(1)) {
        { pg8::Gemm g{F.HN(), F.WinT(), MPAD, ZLD, DM}; pg8::StaticOrder S; S.init(MPAD, ZLD, F.G, (int)blockIdx.x);
          pg8::EpiIn E{F.Z(), F.QNR(), P.out, F.ROPE(), P.a_cmp, F.POOLP()};
          pg8::gemm_phase<pg8::EpiIn, pg8::StaticOrder, false, true>(F.lds, g, S, E); }
        __syncthreads();
        { pg8::Gemm g{F.HM(), F.WmemT(), 1024, 1024, DM}; pg8::StaticOrder S; S.init(1024, 1024, F.G, (int)blockIdx.x);
          pg8::EpiMem E{P.out, F.MKV()};
          pg8::gemm_phase<pg8::EpiMem, pg8::StaticOrder, false, true>(F.lds, g, S, E); }
    }
    SEAM(1);
    if (IN(2)) { p2_cmp_finalize(P, F); }
    SEAM(2);
    if (IN(3)) { att::p3_attention(P, F); }
    SEAM(3);
    if (IN(4)) {
        pg8::Gemm g{F.MIX(), F.WoutT(), MPAD, DM, DM}; pg8::StaticOrder S; S.init(MPAD, DM, F.G, (int)blockIdx.x);
        pg8::EpiOut E{P.x_prompt, P.x_sample, P.out, F.SS()};
        pg8::gemm_phase<pg8::EpiOut, pg8::StaticOrder, false, true>(F.lds, g, S, E);
    }
    SEAM(4);
    if (IN(5)) { p5_final_norm(P, F); }
#undef IN
#undef SEAM
}

#ifndef MK_N_LAUNCHES
#define MK_N_LAUNCHES 1
#endif
extern "C" void kernel_launch(void* const* d_in, const int* in_sizes, int n_in, void* d_out, int out_size, void* d_ws, size_t ws_size, hipStream_t stream) {
    static int grid = 0;
    if (grid == 0) {
        if (n_in != 17 || (size_t)out_size != OFF_END || ws_size < WS_END) { fprintf(stderr, "kernel_launch: unexpected shapes (n_in %d out %d ws %zu)\n", n_in, out_size, ws_size); grid = -1; return; }
        int dev = 0, cus = 0, per_cu = 0;
        if (hipGetDevice(&dev) != hipSuccess || hipDeviceGetAttribute(&cus, hipDeviceAttributeMultiprocessorCount, dev) != hipSuccess) { grid = -1; return; }
        if (hipFuncSetAttribute((const void*)fwd_megakernel, hipFuncAttributeMaxDynamicSharedMemorySize, LDS_BYTES) != hipSuccess) { fprintf(stderr, "kernel_launch: hipFuncSetAttribute failed\n"); grid = -1; return; }
        if (hipOccupancyMaxActiveBlocksPerMultiprocessor(&per_cu, (const void*)fwd_megakernel, NTHREADS, LDS_BYTES) != hipSuccess || per_cu < 1) { fprintf(stderr, "kernel_launch: occupancy query says %d\n", per_cu); (void)hipGetLastError(); grid = -1; return; }
        grid = cus;
    }
    if (grid < 0) return;
    (void)hipMemsetAsync((char*)d_ws + WS_CTL, 0, CTL_BYTES, stream);
    Params p{};
    p.x_prompt = (const float*)d_in[0]; p.x_sample = (const float*)d_in[1]; p.cache_kv = (const float*)d_in[2]; p.cache_win = (const float*)d_in[3];
    p.state_conv = (const float*)d_in[4]; p.cache_mem = (const float*)d_in[5]; p.page_table = (const int*)d_in[6]; p.mem_prompt = (const float*)d_in[7];
    p.norm_g = (const float*)d_in[8]; p.w_in = (const float*)d_in[9]; p.w_conv = (const float*)d_in[10]; p.a_cmp = (const float*)d_in[11]; p.w_cmp = (const float*)d_in[12];
    p.mem_norm_g = (const float*)d_in[13]; p.w_mem_kv = (const float*)d_in[14]; p.w_out = (const float*)d_in[15]; p.final_g = (const float*)d_in[16];
    p.out = (float*)d_out; p.ws = (unsigned char*)d_ws;
#if MK_N_LAUNCHES == 1
    p.ph_lo = 0; p.ph_hi = N_PHASES;
    void* args[] = {&p};
    hipError_t e = hipLaunchCooperativeKernel((const void*)fwd_megakernel, dim3(grid), dim3(NTHREADS), args, LDS_BYTES, stream);
    if (e != hipSuccess) fprintf(stderr, "kernel_launch: cooperative launch failed: %s (grid %d)\n", hipGetErrorString(e), grid);
#else
    for (int k = 0; k < N_PHASES; ++k) { p.ph_lo = k; p.ph_hi = k + 1; hipLaunchKernelGGL(fwd_megakernel, dim3(grid), dim3(NTHREADS), LDS_BYTES, stream, p); }
#endif
}
```

```cpp
#include <hip/hip_runtime.h>
#include <hip/hip_cooperative_groups.h>
#include <cstdio>
#include <cstdint>
namespace cg = cooperative_groups;

constexpr int DM = 2048, PB = 4, PT = 2048, MP = PB * PT, SBATCH = 8, STOK = 4, MS = SBATCH * STOK, MALL = MP + MS, MPAD = 8448;
constexpr int INW = 6680, ZLD = 6912;
constexpr int ZC_CH = 0, ZC_CB = 512, ZC_CC = 1024, ZC_CG = 1536, ZC_Q = 2048, ZC_NG = 3072, ZC_KV = 4096, ZC_MQ = 5632, ZC_MG = 6144, ZC_BG = 6656;
constexpr int PAST = 16384, NPAGES = 128;
constexpr float NORM_EPS = 1e-6f;
constexpr size_t OFF_YP = 0, OFF_YS = OFF_YP + (size_t)MP * DM, OFF_KVP = OFF_YS + (size_t)MS * DM, OFF_WINP = OFF_KVP + (size_t)MP * 1024,
                 OFF_CONVP = OFF_WINP + (size_t)PB * 512 * 512, OFF_MEMP = OFF_CONVP + (size_t)PB * 2 * 512, OFF_KVS = OFF_MEMP + (size_t)PB * 256 * 1024,
                 OFF_WINS = OFF_KVS + (size_t)MS * 1024, OFF_CONVS = OFF_WINS + (size_t)SBATCH * 512 * 512, OFF_END = OFF_CONVS + (size_t)SBATCH * 2 * 512;
constexpr size_t MiB = 1u << 20;
constexpr size_t WS_CTL = 0, CTL_BYTES = 1 * MiB;
constexpr size_t WS_WIN = 1 * MiB, WS_WOUT = 28 * MiB, WS_WMEM = 36 * MiB, WS_HN = 40 * MiB, WS_HM = 73 * MiB, WS_Z = 77 * MiB, WS_MIX = 189 * MiB,
                 WS_MKV = 222 * MiB, WS_QNR = 224 * MiB, WS_POOLP = 229 * MiB, WS_POOLS = 230 * MiB, WS_KCP = 234 * MiB, WS_VCP = WS_KCP + 131072,
                 WS_KCS = 235 * MiB, WS_VCS = 236 * MiB, WS_ROPE = 237 * MiB, WS_TOT = 273 * MiB, WS_KV4 = 254 * MiB, WS_SSP = 271 * MiB, WS_SWIN = 322 * MiB, WS_SMB = 327 * MiB, WS_SELS = 332 * MiB, WS_XB = 368 * MiB, WS_END = 369 * MiB;
static_assert(WS_WIN + (size_t)ZLD * DM * 2 <= WS_WOUT && WS_HN + (size_t)MPAD * DM * 2 <= WS_HM && WS_Z + (size_t)MPAD * ZLD * 2 <= WS_MIX && WS_MIX + (size_t)MPAD * DM * 2 <= WS_MKV &&
              WS_QNR + (size_t)MPAD * 256 * 2 <= WS_POOLP && WS_POOLS + (size_t)SBATCH * 256 * 512 * 4 <= WS_KCP && WS_ROPE + 2052 * 32 * 4 <= WS_KV4 && WS_TOT + (size_t)256 * 4 * 3 * 4096 * 4 <= WS_END && WS_SSP + ((size_t)MP * 32 + MS * 256) * 4 <= WS_TOT && WS_KV4 + (size_t)4 * 8 * 2048 * 128 * 2 <= WS_SSP, "ws map");

#ifndef PROBE_PHASE
#define PROBE_PHASE -1
#endif
constexpr int NWAVES = 8, NTHREADS = 512;
constexpr int LDS_BYTES = 159744;

#define LAS __attribute__((address_space(3)))
typedef LAS unsigned char lbyte;
namespace pg8 {
#define PG8_LAS __attribute__((address_space(3)))
typedef unsigned short bf16_t;
typedef short bf16x8 __attribute__((ext_vector_type(8)));
typedef float f32x4 __attribute__((ext_vector_type(4)));
typedef unsigned u32x4 __attribute__((ext_vector_type(4)));
constexpr int BM = 256, BK = 64, HALF = 128, HTB = HALF * BK * 2  , STAGE_BYTES = 8 * HTB, NXCD = 8, WGM = 2;

__host__ __device__ __forceinline__ int lds_byte(int r, int c) { const int st = (r >> 4) * 2 + (c >> 5), rr = r & 15, cc = c & 31, ob = rr * 64 + cc * 2; return st * 1024 + (ob ^ (((ob >> 9) & 1) << 5)); }
__host__ __device__ __forceinline__ void stage_rc(int b, int& R, int& C) { const int st = b / 1024, sb = b % 1024, swz = sb ^ (((sb >> 9) & 1) << 5); R = (st >> 1) * 16 + swz / 64; C = (st & 1) * 32 + (swz % 64) / 2; }
__host__ __device__ __forceinline__ int perm32(int rho) { const int n = rho >> 4, i = rho & 15; return 8 * (i >> 2) + 4 * n + (i & 3); }

struct Unit { int pm, pn, which; };
struct Gemm { const bf16_t* A; const bf16_t* Bt; int M, N, K; const bf16_t* A2; const bf16_t* Bt2; };

struct StaticOrder {
    int nM, nN, nwg, G, c;
    __host__ __device__ void init(int M, int N, int G_, int c_) { nM = M / BM; nN = N / BM; nwg = nM * nN; G = G_; c = c_; }
    __host__ __device__ bool next(int i, Unit& u) const {
        const long L = (long)i * G + c; if (L >= nwg) return false;
        int wgid = (int)L; { const int q = nwg / NXCD, r = nwg % NXCD, xcd = wgid % NXCD, off = wgid / NXCD; wgid = (xcd < r ? xcd * (q + 1) : r * (q + 1) + (xcd - r) * q) + off; }
        const int nig = WGM * nN, gid = wgid / nig, fm = gid * WGM, gsz = (nM - fm) < WGM ? (nM - fm) : WGM;
        u.pm = fm + ((wgid % nig) % gsz); u.pn = (wgid % nig) / gsz; u.which = 0; return true;
    }
    __device__ __forceinline__ void a_ready(const Unit&) const {}
    __device__ __forceinline__ void done(const Unit&) const {}
};

__device__ __forceinline__ unsigned cvt_pk_bf16(float lo, float hi) { unsigned r; asm volatile("v_cvt_pk_bf16_f32 %0, %1, %2" : "=v"(r) : "v"(lo), "v"(hi)); return r; }
typedef float f32x2 __attribute__((ext_vector_type(2)));
template <class Epi, class Sched, bool ALIGN_EPI = false, bool SP2 = false>
__device__ __forceinline__ void gemm_phase(PG8_LAS unsigned char* lds, const Gemm g, const Sched& S, const Epi& E) {
    const int tid = threadIdx.x, wid = __builtin_amdgcn_readfirstlane(tid >> 6), lane = tid & 63, wr = wid >> 2, wc = wid & 3, fr = lane & 15, fq = lane >> 4;
    const int K = g.K, nt = K / BK;
    unsigned voffA[2], voffB[2];
#pragma unroll
    for (int i = 0; i < 2; ++i) { int R, C; stage_rc(tid * 16 + i * 8192, R, C); const int Rb = Epi::PERM ? ((R & ~31) + perm32(R & 31)) : R;
        voffA[i] = (unsigned)(R * K + C) * 2u; voffB[i] = (unsigned)(Rb * K + C) * 2u; }
    const size_t kstep = (size_t)(BK * 2);
    const size_t hstep = (size_t)HALF * K * 2;
    const size_t tstep = 2 * hstep;
    const unsigned ldsw = (unsigned)wid * 1024u;
    const int aoff = lds_byte(wr * 64 + fr, fq * 8), boff = lds_byte(wc * 32 + fr, fq * 8);
#define PG8_SA(b, h) (((b) * 2 + (h)) * HTB)
#define PG8_SB(b, h) ((4 + (b) * 2 + (h)) * HTB)
#define PG8_STAGE(bufoff, gbase, voff) do { _Pragma("unroll") for (int _i = 0; _i < 2; ++_i) \
        __builtin_amdgcn_global_load_lds((const unsigned*)((const char*)(gbase) + (voff)[_i]), (PG8_LAS unsigned*)(lds + (bufoff) + ldsw + _i * 8192), 16, 0, 0); } while (0)
#define PG8_LDA(dst, b, h) do { _Pragma("unroll") for (int m = 0; m < 4; ++m) _Pragma("unroll") for (int k = 0; k < 2; ++k) dst[m][k] = *(const PG8_LAS bf16x8*)(lds + PG8_SA(b, h) + aoff + m * 2048 + k * 1024); } while (0)
#define PG8_LDB(dst, b, h) do { _Pragma("unroll") for (int n = 0; n < 2; ++n) _Pragma("unroll") for (int k = 0; k < 2; ++k) dst[n][k] = *(const PG8_LAS bf16x8*)(lds + PG8_SB(b, h) + boff + n * 2048 + k * 1024); } while (0)
#define PG8_MMA(ai, bj, At, Bt) do { __builtin_amdgcn_s_setprio(1); _Pragma("unroll") for (int m = 0; m < 4; ++m) _Pragma("unroll") for (int n = 0; n < 2; ++n) _Pragma("unroll") for (int k = 0; k < 2; ++k) \
        acc[ai][bj][m][n] = __builtin_amdgcn_mfma_f32_16x16x32_bf16(Bt[n][k], At[m][k], acc[ai][bj][m][n], 0, 0, 0); __builtin_amdgcn_s_setprio(0); } while (0)
#define PG8_WAIT_V(n) asm volatile("s_waitcnt vmcnt(" #n ")" ::: "memory")
#define PG8_WAIT_L(n) asm volatile("s_waitcnt lgkmcnt(" #n ")" ::: "memory")
#define PG8_BAR __builtin_amdgcn_s_barrier()
#define PG8_SCHED __builtin_amdgcn_sched_barrier(0)
    Unit cur, nxt; int ui = 0;
    if (!S.next(0, cur)) return;
    f32x4 acc[2][2][4][2];
#pragma unroll
    for (int a = 0; a < 2; ++a)
#pragma unroll
        for (int b = 0; b < 2; ++b)
#pragma unroll
            for (int m = 0; m < 4; ++m)
#pragma unroll
                for (int n = 0; n < 2; ++n) acc[a][b][m][n] = (f32x4){0.f, 0.f, 0.f, 0.f};
    bf16x8 At[4][2], B0[2][2], B1[2][2];
    const char* cA = (const char*)(cur.which ? g.A2 : g.A) + (size_t)cur.pm * tstep; const char* cB = (const char*)(cur.which ? g.Bt2 : g.Bt) + (size_t)cur.pn * tstep;
    S.a_ready(cur);
    if constexpr (SP2) {
        PG8_STAGE(PG8_SB(0, 0), cB, voffB); PG8_STAGE(PG8_SB(0, 1), cB + hstep, voffB); PG8_STAGE(PG8_SA(0, 0), cA, voffA); PG8_STAGE(PG8_SA(0, 1), cA + hstep, voffA);
        if (wr == 1) PG8_BAR;
        PG8_WAIT_V(2); PG8_BAR;
        PG8_STAGE(PG8_SB(1, 0), cB + kstep, voffB); PG8_STAGE(PG8_SA(1, 0), cA + kstep, voffA); PG8_STAGE(PG8_SB(1, 1), cB + hstep + kstep, voffB);
        PG8_WAIT_V(6); PG8_BAR;
    } else {
        PG8_STAGE(PG8_SB(0, 0), cB, voffB); PG8_STAGE(PG8_SA(0, 0), cA, voffA); PG8_STAGE(PG8_SB(0, 1), cB + hstep, voffB); PG8_STAGE(PG8_SA(0, 1), cA + hstep, voffA);
        if (wr == 1) PG8_BAR;
        PG8_WAIT_V(4); PG8_BAR;
        PG8_STAGE(PG8_SB(1, 0), cB + kstep, voffB); PG8_STAGE(PG8_SA(1, 0), cA + kstep, voffA); PG8_STAGE(PG8_SB(1, 1), cB + hstep + kstep, voffB);
        PG8_WAIT_V(6); PG8_BAR;
    }
    for (;;) {
        const bool has_next = S.next(ui + 1, nxt);
        const char* nA = has_next ? (const char*)(nxt.which ? g.A2 : g.A) + (size_t)nxt.pm * tstep : cA; const char* nB = has_next ? (const char*)(nxt.which ? g.Bt2 : g.Bt) + (size_t)nxt.pn * tstep : cB;
        for (int t = 0; t < nt; t += 2) {
            const bool last = (t == nt - 2);
            const char* a1 = cA + (size_t)(t + 1) * kstep;
            const char* a2 = last ? nA : cA + (size_t)(t + 2) * kstep; const char* b2 = last ? nB : cB + (size_t)(t + 2) * kstep;
            const char* a3 = a2 + kstep; const char* b3 = b2 + kstep;
            if (last && has_next) S.a_ready(nxt);
            if constexpr (SP2) {
            PG8_LDB(B0, 0, 0); PG8_LDB(B1, 0, 1); PG8_SCHED; PG8_LDA(At, 0, 0); PG8_STAGE(PG8_SA(1, 1), a1 + hstep, voffA);
            PG8_WAIT_V(8); PG8_WAIT_L(0); PG8_BAR; PG8_MMA(0, 0, At, B0); PG8_MMA(0, 1, At, B1); PG8_BAR; PG8_SCHED;
            PG8_LDA(At, 0, 1); PG8_STAGE(PG8_SB(0, 0), b2, voffB); PG8_STAGE(PG8_SB(0, 1), b2 + hstep, voffB); PG8_STAGE(PG8_SA(0, 0), a2, voffA);
            PG8_WAIT_V(8); PG8_WAIT_L(0); PG8_BAR; PG8_MMA(1, 0, At, B0); PG8_MMA(1, 1, At, B1); PG8_BAR; PG8_SCHED;
            PG8_LDB(B0, 1, 0); PG8_LDB(B1, 1, 1); PG8_SCHED; PG8_LDA(At, 1, 0); PG8_STAGE(PG8_SA(0, 1), a2 + hstep, voffA);
            PG8_WAIT_V(8); PG8_WAIT_L(0); PG8_BAR; PG8_MMA(0, 0, At, B0); PG8_MMA(0, 1, At, B1); PG8_BAR; PG8_SCHED;
            PG8_LDA(At, 1, 1); PG8_STAGE(PG8_SB(1, 0), b3, voffB); PG8_STAGE(PG8_SB(1, 1), b3 + hstep, voffB); PG8_STAGE(PG8_SA(1, 0), a3, voffA);
            PG8_WAIT_V(8); PG8_WAIT_L(0); PG8_BAR; PG8_MMA(1, 0, At, B0); PG8_MMA(1, 1, At, B1); PG8_BAR; PG8_SCHED;
            } else {
            PG8_LDB(B0, 0, 0); PG8_SCHED; PG8_LDA(At, 0, 0); PG8_STAGE(PG8_SA(1, 1), a1 + hstep, voffA);
            PG8_WAIT_L(8); PG8_BAR; PG8_WAIT_L(0); PG8_MMA(0, 0, At, B0); PG8_BAR; PG8_SCHED;
            PG8_LDB(B1, 0, 1); PG8_STAGE(PG8_SB(0, 0), b2, voffB);
            PG8_BAR; PG8_WAIT_L(0); PG8_MMA(0, 1, At, B1); PG8_BAR;
            PG8_LDA(At, 0, 1); PG8_STAGE(PG8_SA(0, 0), a2, voffA);
            PG8_BAR; PG8_WAIT_L(0); PG8_MMA(1, 0, At, B0); PG8_BAR; PG8_SCHED;
            PG8_STAGE(PG8_SB(0, 1), b2 + hstep, voffB);
            PG8_WAIT_V(6); PG8_BAR; PG8_MMA(1, 1, At, B1); PG8_BAR;
            PG8_LDB(B0, 1, 0); PG8_SCHED; PG8_LDA(At, 1, 0); PG8_STAGE(PG8_SA(0, 1), a2 + hstep, voffA);
            PG8_WAIT_L(8); PG8_BAR; PG8_WAIT_L(0); PG8_MMA(0, 0, At, B0); PG8_BAR; PG8_SCHED;
            PG8_LDB(B1, 1, 1); PG8_STAGE(PG8_SB(1, 0), b3, voffB);
            PG8_BAR; PG8_WAIT_L(0); PG8_MMA(0, 1, At, B1); PG8_BAR;
            PG8_LDA(At, 1, 1); PG8_STAGE(PG8_SA(1, 0), a3, voffA);
            PG8_BAR; PG8_WAIT_L(0); PG8_MMA(1, 0, At, B0); PG8_BAR; PG8_SCHED;
            PG8_STAGE(PG8_SB(1, 1), b3 + hstep, voffB);
            PG8_WAIT_V(6); PG8_BAR; PG8_MMA(1, 1, At, B1); PG8_BAR;
            }
        }
        if constexpr (ALIGN_EPI) { if (wr == 0) PG8_BAR; }
        if constexpr (!Epi::AFTER_DRAIN) { E(acc, cur, wr, wc, fr, fq); S.done(cur); }
        if (!has_next) break;
#pragma unroll
        for (int a = 0; a < 2; ++a)
#pragma unroll
            for (int b = 0; b < 2; ++b)
#pragma unroll
                for (int m = 0; m < 4; ++m)
#pragma unroll
                    for (int n = 0; n < 2; ++n) acc[a][b][m][n] = (f32x4){0.f, 0.f, 0.f, 0.f};
        cur = nxt; cA = nA; cB = nB; ++ui;
        if constexpr (ALIGN_EPI) { if (wr == 1) PG8_BAR; }
    }
    PG8_WAIT_V(0);
    if constexpr (!ALIGN_EPI) { if (wr == 0) PG8_BAR; }
    PG8_BAR;
    if constexpr (Epi::AFTER_DRAIN) { E.fused(acc, cur, wr, wc, fr, fq, lds, wid, lane); S.done(cur); }
#undef PG8_SA
#undef PG8_SB
#undef PG8_STAGE
#undef PG8_LDA
#undef PG8_LDB
#undef PG8_MMA
#undef PG8_WAIT_V
#undef PG8_WAIT_L
#undef PG8_BAR
#undef PG8_SCHED
}
}

namespace pg8 {
typedef unsigned u32x2 __attribute__((ext_vector_type(2)));
struct EpiIn {
    static constexpr bool PERM = false, AFTER_DRAIN = false;
    bf16_t* Z; bf16_t* QNR; float* out; const float* rope; const float* acmp; float* poolp; bf16_t* KV4;
    static __device__ __forceinline__ void st_bf16x4(bf16_t* p, const f32x4 v) { u32x2 w; w.x = cvt_pk_bf16(v[0], v[1]); w.y = cvt_pk_bf16(v[2], v[3]); *(u32x2*)p = w; }
    static __device__ __forceinline__ void st_bf16_rows2(bf16_t* pp, const f32x4 va, const f32x4 vb) {
        unsigned a0 = cvt_pk_bf16(va[0], va[1]), a1 = cvt_pk_bf16(va[2], va[3]), b0 = cvt_pk_bf16(vb[0], vb[1]), b1 = cvt_pk_bf16(vb[2], vb[3]);
        auto s0 = __builtin_amdgcn_permlane16_swap(a0, b0, false, false); auto s1 = __builtin_amdgcn_permlane16_swap(a1, b1, false, false);
        u32x4 w; w.x = s0[0]; w.y = s1[0]; w.z = s0[1]; w.w = s1[1];
        *(u32x4*)pp = w;
    }
    __device__ __forceinline__ void operator()(const f32x4 (&acc)[2][2][4][2], const Unit& u, int wr, int wc, int fr, int fq) const {
        if (u.pm >= MP / BM) { generic(acc, u, wr, wc, fr, fq); return; }
        const int pn = u.pn, row0 = u.pm * BM + wr * 64 + fr, cc0 = wc * 32 + 4 * fq;
        if (pn == 16 || pn == 17) {
            float* o0 = out + OFF_KVP + (size_t)row0 * 1024 + (pn - 16) * 256 + cc0;
#pragma unroll
            for (int ai = 0; ai < 2; ++ai)
#pragma unroll
                for (int m = 0; m < 4; ++m) { float* op = o0 + (size_t)(ai * HALF + m * 16) * 1024;
#pragma unroll
                    for (int bj = 0; bj < 2; ++bj) { __builtin_nontemporal_store(acc[ai][bj][m][0], (f32x4*)(op + bj * HALF)); __builtin_nontemporal_store(acc[ai][bj][m][1], (f32x4*)(op + bj * HALF + 16)); } }
            pool_partials(acc, u, wr, wc, fr, fq, pn - 16);
            return;
        }
        const bool rot = (wc == 0) && ((pn >= 8 && pn < 12) || pn == 18 || pn == 20);
        if (pn >= 18 && pn < 22) {
            const int p = pn - 16; const bool winout = p >= 4 && (u.pm & 7) >= 6;
#pragma unroll
            for (int ai = 0; ai < 2; ++ai)
#pragma unroll
                for (int m = 0; m < 4; ++m) { const int row = row0 + ai * HALF + m * 16, t = row & (PT - 1), b = row >> 11;
                    f32x4 cs4, sn4; if (rot) { cs4 = *(const f32x4*)(rope + t * 32 + 4 * fq); sn4 = *(const f32x4*)(rope + t * 32 + 16 + 4 * fq); }
#pragma unroll
                    for (int bj = 0; bj < 2; ++bj) { f32x4 v0 = acc[ai][bj][m][0], v1 = acc[ai][bj][m][1];
                        if (rot) { const f32x4 r0 = v0 * cs4 - v1 * sn4, r1 = v1 * cs4 + v0 * sn4; v0 = r0; v1 = r1; }
                        bf16_t* kp = KV4 + ((size_t)((pn - 18) * 8 + b * 2 + bj) * PT + t) * 128 + cc0; st_bf16x4(kp, v0); st_bf16x4(kp + 16, v1);
                        float* op = p < 4 ? out + OFF_KVP + (size_t)row * 1024 + p * 256 + bj * HALF + cc0 : out + OFF_WINP + ((size_t)(b * 512 + t - (PT - 512)) * 2 + (p - 4)) * 256 + bj * HALF + cc0;
                        if (p < 4 || winout) { __builtin_nontemporal_store(v0, (f32x4*)op); __builtin_nontemporal_store(v1, (f32x4*)(op + 16)); } } }
            return;
        }
        if (rot) {
#pragma unroll
            for (int ai = 0; ai < 2; ++ai)
#pragma unroll
                for (int m = 0; m < 4; ++m) { const int row = row0 + ai * HALF + m * 16, t = row & (PT - 1);
                    const f32x4 cs4 = *(const f32x4*)(rope + t * 32 + 4 * fq), sn4 = *(const f32x4*)(rope + t * 32 + 16 + 4 * fq);
                    bf16_t* zp = Z + (size_t)row * ZLD + pn * BM + cc0;
#pragma unroll
                    for (int bj = 0; bj < 2; ++bj) { const f32x4 v0 = acc[ai][bj][m][0], v1 = acc[ai][bj][m][1];
                        bf16_t* qp = QNR + ((size_t)row * 8 + (pn - 8) * 2 + bj) * 32 + 4 * fq; st_bf16x4(qp, v0); st_bf16x4(qp + 16, v1);
                        st_bf16x4(zp + bj * HALF, v0 * cs4 - v1 * sn4); st_bf16x4(zp + bj * HALF + 16, v1 * cs4 + v0 * sn4); } }
        } else {
#pragma unroll
            for (int ai = 0; ai < 2; ++ai)
#pragma unroll
                for (int mp = 0; mp < 4; mp += 2) { bf16_t* zp = Z + (size_t)(row0 + ai * HALF + mp * 16 + (fq & 1) * 16) * ZLD + pn * BM + cc0 - (fq & 1) * 4;
#pragma unroll
                    for (int bj = 0; bj < 2; ++bj) { st_bf16_rows2(zp + bj * HALF, acc[ai][bj][mp][0], acc[ai][bj][mp + 1][0]);
                                                     st_bf16_rows2(zp + bj * HALF + 16, acc[ai][bj][mp][1], acc[ai][bj][mp + 1][1]); } }
        }
    }
    __device__ __forceinline__ void pool_partials(const f32x4 (&acc)[2][2][4][2], const Unit& u, int wr, int wc, int fr, int fq, int part) const {
#pragma unroll
        for (int ai = 0; ai < 2; ++ai)
#pragma unroll
            for (int bj = 0; bj < 2; ++bj)
#pragma unroll
                for (int n = 0; n < 2; ++n) {
                    const int d = wc * 32 + n * 16 + 4 * fq;
                    f32x4 s = (f32x4){0.f, 0.f, 0.f, 0.f};
#pragma unroll
                    for (int m = 0; m < 4; ++m) { const f32x4 a = *(const f32x4*)(acmp + ((size_t)part * 64 + m * 16 + fr) * 128 + d); s += a * acc[ai][bj][m][n]; }
#pragma unroll
                    for (int i = 0; i < 4; ++i) { float x = s[i]; x += __shfl_xor(x, 1); x += __shfl_xor(x, 2); x += __shfl_xor(x, 4); x += __shfl_xor(x, 8); s[i] = x; }
                    if (fr == 0) { const int b = u.pm >> 3, nb = (u.pm & 7) * 4 + ai * 2 + wr;
                        *(f32x4*)(poolp + ((((size_t)b * 32 + nb) * 2 + part) * 2 + bj) * 128 + d) = s; }
                }
    }
    __device__ __forceinline__ void generic(const f32x4 (&acc)[2][2][4][2], const Unit& u, int wr, int wc, int fr, int fq) const {
        const int pn = u.pn;
        const bool is_q = (pn >= 8 && pn < 12), is_kv = (pn >= 16 && pn < 22);
        const bool do_rope = (wc == 0) && (is_q || pn == 18 || pn == 20);
        const bool do_z = !(pn == 16 || pn == 17);
#pragma unroll
        for (int ai = 0; ai < 2; ++ai)
#pragma unroll
            for (int m = 0; m < 4; ++m) {
                const int row = u.pm * BM + ai * HALF + wr * 64 + m * 16 + fr;
                if (row >= MALL) continue;
                const int posidx = row < MP ? (row & (PT - 1)) : (PT + ((row - MP) & 3));
                f32x4 cs4 = (f32x4){1.f, 1.f, 1.f, 1.f}, sn4 = (f32x4){0.f, 0.f, 0.f, 0.f};
                if (do_rope) { cs4 = *(const f32x4*)(rope + posidx * 32 + 4 * fq); sn4 = *(const f32x4*)(rope + posidx * 32 + 16 + 4 * fq); }
#pragma unroll
                for (int bj = 0; bj < 2; ++bj) {
                    f32x4 v0 = acc[ai][bj][m][0], v1 = acc[ai][bj][m][1];
                    if (do_rope) {
                        if (is_q) {
                            const int head = (pn - 8) * 2 + bj;
                            bf16_t* qp = QNR + ((size_t)row * 8 + head) * 32 + 4 * fq;
                            u32x2 w0; w0.x = cvt_pk_bf16(v0[0], v0[1]); w0.y = cvt_pk_bf16(v0[2], v0[3]); *(u32x2*)qp = w0;
                            u32x2 w1; w1.x = cvt_pk_bf16(v1[0], v1[1]); w1.y = cvt_pk_bf16(v1[2], v1[3]); *(u32x2*)(qp + 16) = w1;
                        }
                        const f32x4 r0 = v0 * cs4 - v1 * sn4, r1 = v1 * cs4 + v0 * sn4; v0 = r0; v1 = r1;
                    }
                    const int cc = bj * HALF + wc * 32 + 4 * fq;
                    if (pn >= 18 && pn < 22 && row < MP) {
                        bf16_t* kp = KV4 + ((size_t)((pn - 18) * 8 + (row >> 11) * 2 + bj) * PT + (row & (PT - 1))) * 128 + wc * 32 + 4 * fq;
                        u32x2 w0; w0.x = cvt_pk_bf16(v0[0], v0[1]); w0.y = cvt_pk_bf16(v0[2], v0[3]); *(u32x2*)kp = w0;
                        u32x2 w1; w1.x = cvt_pk_bf16(v1[0], v1[1]); w1.y = cvt_pk_bf16(v1[2], v1[3]); *(u32x2*)(kp + 16) = w1;
                    } else if (do_z) {
                        bf16_t* zp = Z + (size_t)row * ZLD + pn * BM + cc;
                        u32x2 w0; w0.x = cvt_pk_bf16(v0[0], v0[1]); w0.y = cvt_pk_bf16(v0[2], v0[3]); *(u32x2*)zp = w0;
                        u32x2 w1; w1.x = cvt_pk_bf16(v1[0], v1[1]); w1.y = cvt_pk_bf16(v1[2], v1[3]); *(u32x2*)(zp + 16) = w1;
                    }
                    if (is_kv) {
                        const int p = pn - 16; float* op = nullptr;
                        if (row < MP) {
                            if (p < 4) op = out + OFF_KVP + (size_t)row * 1024 + p * 256 + cc;
                            else { const int t = row & (PT - 1); if (t >= PT - 512) op = out + OFF_WINP + ((size_t)((row >> 11) * 512 + t - (PT - 512)) * 2 + (p - 4)) * 256 + cc; }
                        } else {
                            const int rs = row - MP;
                            if (p < 4) op = out + OFF_KVS + (size_t)rs * 1024 + p * 256 + cc;
                            else op = out + OFF_WINS + ((size_t)((rs >> 2) * 512 + 508 + (rs & 3)) * 2 + (p - 4)) * 256 + cc;
                        }
                        if (op) { *(f32x4*)op = v0; *(f32x4*)(op + 16) = v1; }
                    }
                }
            }
        if ((pn == 16 || pn == 17) && u.pm < MP / BM) {
            const int part = pn - 16;
#pragma unroll
            for (int ai = 0; ai < 2; ++ai)
#pragma unroll
                for (int bj = 0; bj < 2; ++bj)
#pragma unroll
                    for (int n = 0; n < 2; ++n) {
                        const int d = wc * 32 + n * 16 + 4 * fq;
                        f32x4 s = (f32x4){0.f, 0.f, 0.f, 0.f};
#pragma unroll
                        for (int m = 0; m < 4; ++m) { const f32x4 a = *(const f32x4*)(acmp + ((size_t)part * 64 + m * 16 + fr) * 128 + d); s += a * acc[ai][bj][m][n]; }
#pragma unroll
                        for (int i = 0; i < 4; ++i) { float x = s[i]; x += __shfl_xor(x, 1); x += __shfl_xor(x, 2); x += __shfl_xor(x, 4); x += __shfl_xor(x, 8); s[i] = x; }
                        if (fr == 0) { const int b = u.pm >> 3, nb = (u.pm & 7) * 4 + ai * 2 + wr;
                            *(f32x4*)(poolp + ((((size_t)b * 32 + nb) * 2 + part) * 2 + bj) * 128 + d) = s; }
                    }
        }
    }
};
struct EpiMem {
    static constexpr bool PERM = false, AFTER_DRAIN = false;
    float* out; bf16_t* MKV;
    __device__ __forceinline__ void operator()(const f32x4 (&acc)[2][2][4][2], const Unit& u, int wr, int wc, int fr, int fq) const {
#pragma unroll
        for (int ai = 0; ai < 2; ++ai)
#pragma unroll
            for (int m = 0; m < 4; ++m) {
                const int row = u.pm * BM + ai * HALF + wr * 64 + m * 16 + fr;
#pragma unroll
                for (int bj = 0; bj < 2; ++bj)
#pragma unroll
                    for (int n = 0; n < 2; ++n) {
                        const int c = u.pn * BM + bj * HALF + wc * 32 + n * 16 + 4 * fq; const f32x4 v = acc[ai][bj][m][n];
                        *(f32x4*)(out + OFF_MEMP + (size_t)row * 1024 + c) = v;
                        u32x2 w; w.x = cvt_pk_bf16(v[0], v[1]); w.y = cvt_pk_bf16(v[2], v[3]); *(u32x2*)(MKV + (size_t)row * 1024 + c) = w;
                    }
            }
    }
};
struct EpiOut {
    static constexpr bool PERM = false, AFTER_DRAIN = false;
    const float* xp; float* out; float* ssp;
    __device__ __forceinline__ void operator()(const f32x4 (&acc)[2][2][4][2], const Unit& u, int wr, int wc, int fr, int fq) const {
#pragma unroll
        for (int ai = 0; ai < 2; ++ai)
#pragma unroll
            for (int m = 0; m < 4; ++m) {
                const int row = u.pm * BM + ai * HALF + wr * 64 + m * 16 + fr;
                const float* xr = xp + (size_t)row * DM; float* orow = out + OFF_YP + (size_t)row * DM;
                float q = 0.f;
#pragma unroll
                for (int bj = 0; bj < 2; ++bj)
#pragma unroll
                    for (int n = 0; n < 2; ++n) {
                        const int c = u.pn * BM + bj * HALF + wc * 32 + n * 16 + 4 * fq;
                        const f32x4 v = acc[ai][bj][m][n] + *(const f32x4*)(xr + c);
                        *(f32x4*)(orow + c) = v; q += (v[0] * v[0] + v[1] * v[1]) + (v[2] * v[2] + v[3] * v[3]);
                    }
                q += __shfl_xor(q, 16); q += __shfl_xor(q, 32);
                if (fq == 0) ssp[(size_t)row * 32 + u.pn * 4 + wc] = q;
            }
    }
};
struct EpiOutNorm {
    static constexpr bool PERM = false, AFTER_DRAIN = true;
    const float* xp; float* out; const float* fg; float* xbuf; unsigned* cnt;
    __device__ __forceinline__ void operator()(const f32x4 (&)[2][2][4][2], const Unit&, int, int, int, int) const {}
    __device__ __forceinline__ void fused(f32x4 (&acc)[2][2][4][2], const Unit& u, int wr, int wc, int fr, int fq, PG8_LAS unsigned char* lds, int wid, int lane) const {
        PG8_LAS float* Pl = (PG8_LAS float*)lds;
        PG8_LAS float* Sl = (PG8_LAS float*)(lds + 4096);
        PG8_LAS unsigned* flag = (PG8_LAS unsigned*)(lds + 4096 + 1024);
        const int col0 = u.pn * BM + wc * 32 + 4 * fq;
#pragma unroll
        for (int ai = 0; ai < 2; ++ai)
#pragma unroll
            for (int m = 0; m < 4; ++m) { const int rl = ai * HALF + wr * 64 + m * 16 + fr; const float* xr = xp + (size_t)(u.pm * BM + rl) * DM + col0; float q = 0.f;
#pragma unroll
                for (int bj = 0; bj < 2; ++bj)
#pragma unroll
                    for (int n = 0; n < 2; ++n) { const f32x4 v = acc[ai][bj][m][n] + __builtin_nontemporal_load((const f32x4*)(xr + bj * HALF + n * 16)); acc[ai][bj][m][n] = v; q += (v[0] * v[0] + v[1] * v[1]) + (v[2] * v[2] + v[3] * v[3]); }
                q += __shfl_xor(q, 16); q += __shfl_xor(q, 32);
                if (fq == 0) Pl[rl * 4 + wc] = q;
                if (m & 1) asm volatile("" ::: "memory"); }
        asm volatile("s_waitcnt lgkmcnt(0)" ::: "memory"); __builtin_amdgcn_s_barrier(); asm volatile("" ::: "memory");
        const int row = wid * 64 + lane;
        if (wid < 4) { const float s = (Pl[row * 4] + Pl[row * 4 + 1]) + (Pl[row * 4 + 2] + Pl[row * 4 + 3]);
            __hip_atomic_store(xbuf + (size_t)(u.pm * BM + row) * 8 + u.pn, s, __ATOMIC_RELAXED, __HIP_MEMORY_SCOPE_AGENT);
            asm volatile("s_waitcnt vmcnt(0)" ::: "memory");
            if (lane == 0) __hip_atomic_fetch_add(cnt + 64 * u.pm, 1u, __ATOMIC_RELAXED, __HIP_MEMORY_SCOPE_AGENT); }
        if (wid == 0) { unsigned sp = 0;
            while ((unsigned)__builtin_amdgcn_readfirstlane(__hip_atomic_load(cnt + 64 * u.pm, __ATOMIC_RELAXED, __HIP_MEMORY_SCOPE_AGENT)) < 32u) { __builtin_amdgcn_s_sleep(2); if (++sp > (1u << 22)) break; }
            __builtin_amdgcn_fence(__ATOMIC_ACQUIRE, "agent");
            if (lane == 0) flag[0] = 1u; }
        asm volatile("s_waitcnt vmcnt(0) lgkmcnt(0)" ::: "memory"); __builtin_amdgcn_s_barrier(); asm volatile("" ::: "memory");
        if (wid < 4) { float t = 0.f;
#pragma unroll
            for (int k = 0; k < 8; ++k) t += __hip_atomic_load(xbuf + (size_t)(u.pm * BM + row) * 8 + k, __ATOMIC_RELAXED, __HIP_MEMORY_SCOPE_AGENT);
            Sl[row] = 1.0f / sqrtf(t * (1.f / DM) + NORM_EPS); }
        asm volatile("s_waitcnt lgkmcnt(0)" ::: "memory"); __builtin_amdgcn_s_barrier(); asm volatile("" ::: "memory");
        f32x4 gv[2][2];
#pragma unroll
        for (int bj = 0; bj < 2; ++bj)
#pragma unroll
            for (int n = 0; n < 2; ++n) gv[bj][n] = *(const f32x4*)(fg + col0 + bj * HALF + n * 16);
#pragma unroll
        for (int ai = 0; ai < 2; ++ai)
#pragma unroll
            for (int m = 0; m < 4; ++m) { const int rl = ai * HALF + wr * 64 + m * 16 + fr; const float rs = Sl[rl]; float* orow = out + OFF_YP + (size_t)(u.pm * BM + rl) * DM + col0;
#pragma unroll
                for (int bj = 0; bj < 2; ++bj)
#pragma unroll
                    for (int n = 0; n < 2; ++n) __builtin_nontemporal_store(acc[ai][bj][m][n] * rs * gv[bj][n], (f32x4*)(orow + bj * HALF + n * 16)); }
    }
};
struct DualOrder {
    StaticOrder s0; int n0, n1, nN1;
    __host__ __device__ void init(int M0, int N0, int M1, int N1, int G_, int c_) { s0.init(M0, N0, G_, c_); n0 = s0.nwg; nN1 = N1 / BM; n1 = (M1 / BM) * nN1; }
    __host__ __device__ bool next(int i, Unit& u) const {
        const long L = (long)i * s0.G + s0.c; if (L >= n0 + n1) return false;
        if (L < n0) return s0.next(i, u);
        const int r = (int)(L - n0); u.pm = r / nN1; u.pn = r % nN1; u.which = 1; return true;
    }
    __device__ __forceinline__ void a_ready(const Unit&) const {}
    __device__ __forceinline__ void done(const Unit&) const {}
};
struct EpiDual {
    static constexpr bool PERM = false, AFTER_DRAIN = false;
    EpiIn e0; EpiMem e1;
    __device__ __forceinline__ void operator()(const f32x4 (&acc)[2][2][4][2], const Unit& u, int wr, int wc, int fr, int fq) const { if (u.which) e1(acc, u, wr, wc, fr, fq); else { e0(acc, u, wr, wc, fr, fq); if (PROBE_PHASE == 70) { asm volatile("" ::: "memory"); e0(acc, u, wr, wc, fr, fq); } } }
};
}

typedef unsigned short bf16;
typedef unsigned v4u __attribute__((ext_vector_type(4)));
typedef unsigned v2u __attribute__((ext_vector_type(2)));
typedef float f32x4 __attribute__((ext_vector_type(4)));
typedef float f32x2 __attribute__((ext_vector_type(2)));
typedef float f32x16 __attribute__((ext_vector_type(16)));
typedef short bf16x8 __attribute__((ext_vector_type(8)));
typedef short s16x4 __attribute__((ext_vector_type(4)));
#define LDS_WAIT() asm volatile("s_waitcnt lgkmcnt(0)" ::: "memory")
__device__ __forceinline__ unsigned cvtpk(float lo, float hi) { unsigned r; asm volatile("v_cvt_pk_bf16_f32 %0, %1, %2" : "=v"(r) : "v"(lo), "v"(hi)); return r; }
__device__ __forceinline__ float bf2f(bf16 v) { return __uint_as_float(((unsigned)v) << 16); }
__device__ __forceinline__ float wave_sum(float v) {
#pragma unroll
    for (int o = 1; o < 64; o <<= 1) v += __shfl_xor(v, o);
    return v;
}

struct Params {
    const float* x_prompt; const float* x_sample; const float* cache_kv; const float* cache_win; const float* state_conv; const float* cache_mem;
    const int* page_table; const float* mem_prompt; const float* norm_g; const float* w_in; const float* w_conv; const float* a_cmp; const float* w_cmp;
    const float* mem_norm_g; const float* w_mem_kv; const float* w_out; const float* final_g;
    float* out; unsigned char* ws; int ph_lo, ph_hi;
};
struct Frame {
    lbyte* lds; int tid, lane, wave, vcu, G; unsigned char* ws;
#define WSP(T, name, off) __device__ __forceinline__ T* name() const { return (T*)(ws + (off)); }
    WSP(bf16, WinT, WS_WIN) WSP(bf16, WoutT, WS_WOUT) WSP(bf16, WmemT, WS_WMEM) WSP(bf16, HN, WS_HN) WSP(bf16, HM, WS_HM) WSP(bf16, Z, WS_Z) WSP(bf16, MIX, WS_MIX) WSP(bf16, MKV, WS_MKV)
    WSP(bf16, QNR, WS_QNR) WSP(bf16, KCP, WS_KCP) WSP(bf16, VCP, WS_VCP) WSP(bf16, KCS, WS_KCS) WSP(bf16, VCS, WS_VCS)
    WSP(float, POOLP, WS_POOLP) WSP(float, POOLS, WS_POOLS) WSP(float, ROPE, WS_ROPE) WSP(float, SS, WS_CTL + 4096) WSP(unsigned, QUEUE, WS_CTL) WSP(float, TOT, WS_TOT) WSP(bf16, KV4, WS_KV4) WSP(float, SSP, WS_SSP) WSP(bf16, SWIN, WS_SWIN) WSP(bf16, SMB, WS_SMB) WSP(bf16, SELS, WS_SELS) WSP(float, XB, WS_XB)
#undef WSP
};

template <int MODE  >
__device__ __forceinline__ void p0_transpose_item(const float* W, int K, int N, bf16* WT, LAS float* scr, int nblk, int item, int lane) {
    const int kb = item / nblk, nb = item % nblk, k0 = 64 * kb, n0 = 64 * nb;
    const int c4 = (lane & 15) * 4, kr = lane >> 4;
    int sc = n0 + c4;
    if (MODE == 1) { const int zc = sc; sc = zc < ZC_KV ? zc : (zc < ZC_BG ? zc + 24 : (zc < INW ? zc - ZC_BG + 4096 : -1)); }
    f32x4 v[16];
#pragma unroll
    for (int i = 0; i < 16; ++i) v[i] = sc >= 0 ? __builtin_nontemporal_load((const f32x4*)(W + (size_t)(k0 + 4 * i + kr) * N + sc)) : (f32x4){0.f, 0.f, 0.f, 0.f};
#pragma unroll
    for (int i = 0; i < 16; ++i) *(LAS f32x4*)(scr + (4 * i + kr) * 64 + (c4 ^ ((((4 * i + kr) >> 3) & 7) << 2))) = v[i];
    LDS_WAIT(); asm volatile("" ::: "memory");
    const int c = lane & 7;
#pragma unroll
    for (int j = 0; j < 8; ++j) { const int n = (lane >> 3) + 8 * j; const LAS float* s = scr + (8 * c) * 64 + (n ^ (c << 2));
        v4u o; o.x = cvtpk(s[0 * 64], s[1 * 64]); o.y = cvtpk(s[2 * 64], s[3 * 64]); o.z = cvtpk(s[4 * 64], s[5 * 64]); o.w = cvtpk(s[6 * 64], s[7 * 64]);
        *(v4u*)(WT + (size_t)(n0 + n) * K + k0 + 8 * c) = o; }
    LDS_WAIT(); asm volatile("" ::: "memory");
}
__device__ __forceinline__ void rms_row_to_bf16(const float* xrow, const float* g, bf16* orow, int lane) {
    const f32x4* xr = (const f32x4*)xrow + lane; const f32x4* gr = (const f32x4*)g + lane;
    f32x4 v[8]; float s = 0.f;
#pragma unroll
    for (int j = 0; j < 8; ++j) { v[j] = __builtin_nontemporal_load(xr + 64 * j); s += (v[j].x * v[j].x + v[j].y * v[j].y) + (v[j].z * v[j].z + v[j].w * v[j].w); }
    const float rstd = 1.0f / sqrtf(wave_sum(s) * (1.f / DM) + NORM_EPS);
    v2u* o8 = (v2u*)orow + lane;
#pragma unroll
    for (int j = 0; j < 8; ++j) { const f32x4 gg = gr[64 * j]; v2u w; w.x = cvtpk(v[j].x * rstd * gg.x, v[j].y * rstd * gg.y); w.y = cvtpk(v[j].z * rstd * gg.z, v[j].w * rstd * gg.w); o8[64 * j] = w; }
}
__device__ __forceinline__ void pool_sample(const Params& P, Frame& F, int k, int nidle, int NI) {
    LAS f32x4* red = (LAS f32x4*)F.lds;
    const int c4 = F.tid & 127, rg = F.tid >> 7;
    const int part = c4 >> 6, d = (c4 * 4) & 127;
    f32x4 av[16];
#pragma unroll
    for (int i = 0; i < 16; ++i) av[i] = *(const f32x4*)(P.a_cmp + ((size_t)part * 64 + rg + 4 * i) * 128 + d);
    f32x4 xa[16], xb[16];
#define POOL_LOAD(X, it) do { const int b_ = (it) >> 8, n_ = (it) & 255; const int page_ = P.page_table[b_ * NPAGES + (n_ >> 1)]; \
        const float* base_ = P.cache_kv + ((size_t)page_ * 128 + (n_ & 1) * 64 + rg) * 1024 + c4 * 4; \
        _Pragma("unroll") for (int i = 0; i < 16; ++i) X[i] = __builtin_nontemporal_load((const f32x4*)(base_ + (size_t)i * 4096)); } while (0)
#define POOL_REDUCE(X, it) do { f32x4 acc_ = (f32x4){0.f, 0.f, 0.f, 0.f}; _Pragma("unroll") for (int i = 0; i < 16; ++i) acc_ += av[i] * X[i]; \
        red[rg * 128 + c4] = acc_; __syncthreads(); \
        if (F.tid < 128) { const f32x4 s_ = (red[c4] + red[128 + c4]) + (red[256 + c4] + red[384 + c4]); *(f32x4*)(F.POOLS() + (size_t)(it) * 512 + c4 * 4) = s_; } \
        __syncthreads(); } while (0)
    int it = k;
    if (it < NI) POOL_LOAD(xa, it);
    while (it < NI) {
        const int it1 = it + nidle; if (it1 < NI) POOL_LOAD(xb, it1);
        POOL_REDUCE(xa, it);
        if (it1 >= NI) break;
        const int it2 = it1 + nidle; if (it2 < NI) POOL_LOAD(xa, it2);
        POOL_REDUCE(xb, it1);
        it = it2;
    }
#undef POOL_LOAD
#undef POOL_REDUCE
}
__device__ __forceinline__ void p0_prologue(const Params& P, Frame& F) {
    {
        LAS float* scr = (LAS float*)(F.lds + F.wave * 16384);
        constexpr int I_IN = (DM / 64) * (ZLD / 64), I_OUT = (DM / 64) * (DM / 64), I_MEM = (DM / 64) * (1024 / 64), I_T = I_IN + I_OUT + I_MEM, I_R = MPAD + 1024;
        constexpr int I_MIN = I_T < I_R ? I_T : I_R;
        LAS int* const pq = (LAS int*)(F.lds + 131072);
        for (;;) {
            if (F.tid == 0) pq[0] = (int)atomicAdd(F.QUEUE() + 64 * 13, 1u);
            __syncthreads();
            const int base = pq[0] * 32;
            __syncthreads();
            if (base >= I_T + I_R) break;
            for (int it = base + 4 * F.wave; it < base + 4 * F.wave + 4 && it < I_T + I_R; ++it) {
                int kind, r;
                if (it < 2 * I_MIN) { kind = it & 1; r = it >> 1; } else { kind = I_T < I_R ? 1 : 0; r = it - I_MIN; }
                if (kind == 0) {
                    if (r < I_IN) p0_transpose_item<1>(P.w_in, DM, INW, F.WinT(), scr, ZLD / 64, r, F.lane);
                    else if (r < I_IN + I_OUT) p0_transpose_item<0>(P.w_out, DM, DM, F.WoutT(), scr, DM / 64, r - I_IN, F.lane);
                    else p0_transpose_item<0>(P.w_mem_kv, DM, 1024, F.WmemT(), scr, 1024 / 64, r - I_IN - I_OUT, F.lane);
                } else {
                    const int m = r;
                    if (m >= MALL && m < MPAD) { v4u z = (v4u){0u, 0u, 0u, 0u}; v4u* o = (v4u*)(F.HN() + (size_t)m * DM) + F.lane;
#pragma unroll
                        for (int j = 0; j < 4; ++j) o[64 * j] = z; }
                    else { const float* xr = m < MP ? P.x_prompt + (size_t)m * DM : (m < MALL ? P.x_sample + (size_t)(m - MP) * DM : P.mem_prompt + (size_t)(m - MPAD) * DM);
                           const float* gp = m < MALL ? P.norm_g : P.mem_norm_g; bf16* op = m < MALL ? F.HN() + (size_t)m * DM : F.HM() + (size_t)(m - MPAD) * DM;
                           rms_row_to_bf16(xr, gp, op, F.lane); }
                }
            }
        }
    }
    {
        const int gt = F.vcu * NTHREADS + F.tid, NGT = F.G * NTHREADS;
        for (int i = gt; i < 2052 * 16; i += NGT) {
            const int pi = i >> 4, k = i & 15; const float pos = (float)(pi < PT ? pi : PAST + (pi - PT));
            const float fr = powf(500000.0f, -(float)k * (2.0f / 32.0f)); const float ang = pos * fr;
            float sn, cs; sincosf(ang, &sn, &cs); F.ROPE()[pi * 32 + k] = cs; F.ROPE()[pi * 32 + 16 + k] = sn;
        }
        constexpr int NCP = SBATCH * 508 * 128;
        for (int i = gt; i < NCP; i += NGT) { const int b = i / (508 * 128), r = i - b * (508 * 128);
            ((f32x4*)(P.out + OFF_WINS + (size_t)b * 512 * 512))[r] = ((const f32x4*)(P.cache_win + (size_t)b * 512 * 512 + 4 * 512))[r]; }
    }
}

__device__ __forceinline__ void p2_cmp_finalize(const Params& P, Frame& F) {
    const int gw = F.vcu * NWAVES + F.wave, NGW = F.G * NWAVES;
    constexpr int NP = PB * 32 * 4, NS = SBATCH * 256 * 4;
    { const f32x4* src = (const f32x4*)P.w_cmp; LAS f32x4* dst = (LAS f32x4*)F.lds;
#pragma unroll 4
      for (int i = 0; i < 16; ++i) dst[F.tid + 512 * i] = src[F.tid + 512 * i]; }
    __syncthreads();
    for (int it = gw; it < NP + NS; it += NGW) {
        const float* src; bf16* dst; int part;
        if (it < NP) { const int g = it & 1; part = (it >> 1) & 1; const int n = (it >> 2) & 31, b = it >> 7; src = F.POOLP() + (size_t)it * 128; dst = (part ? F.VCP() : F.KCP()) + ((size_t)(b * 2 + g) * 64 + n) * 128; }
        else { const int i2 = it - NP; const int g = i2 & 1; part = (i2 >> 1) & 1; const int n = (i2 >> 2) & 255, b = i2 >> 10; src = F.POOLS() + (size_t)i2 * 128; dst = (part ? F.VCS() : F.KCS()) + ((size_t)(b * 2 + g) * 256 + n) * 128; }
        const float p0 = src[F.lane], p1 = src[64 + F.lane];
        const LAS float* w = (const LAS float*)F.lds + part * 128 * 128 + 2 * F.lane;
        float a0 = 0.f, a1 = 0.f;
#pragma unroll 16
        for (int d = 0; d < 64; ++d) { const float pd = __shfl(p0, d); const f32x2 ww = *(const LAS f32x2*)(w + d * 128); a0 += pd * ww.x; a1 += pd * ww.y; }
#pragma unroll 16
        for (int d = 0; d < 64; ++d) { const float pd = __shfl(p1, d); const f32x2 ww = *(const LAS f32x2*)(w + (64 + d) * 128); a0 += pd * ww.x; a1 += pd * ww.y; }
        *(unsigned*)(dst + 2 * F.lane) = cvtpk(a0, a1);
    }
    { const int gt2 = F.vcu * NTHREADS + F.tid, NGT2 = F.G * NTHREADS;
      for (int i = gt2; i < SBATCH * 512 * 64; i += NGT2) {
          const int c8 = i & 15, g = (i >> 4) & 1, kv = (i >> 5) & 1, row = (i >> 6) & 511, b = i >> 15;
          const float* src = P.cache_win + ((((size_t)b * 512 + row) * 2 + kv) * 2 + g) * 128 + c8 * 8;
          const f32x4 a0 = __builtin_nontemporal_load((const f32x4*)src), a1 = __builtin_nontemporal_load((const f32x4*)(src + 4));
          v4u o; o.x = cvtpk(a0[0], a0[1]); o.y = cvtpk(a0[2], a0[3]); o.z = cvtpk(a1[0], a1[1]); o.w = cvtpk(a1[2], a1[3]);
          *(v4u*)(F.SWIN() + ((((size_t)b * 2 + g) * 2 + kv) * 512 + row) * 128 + c8 * 8) = o; }
      for (int i = gt2; i < SBATCH * 256 * 128; i += NGT2) {
          const int c8 = i & 15, h = (i >> 4) & 3, kv = (i >> 6) & 1, n = (i >> 7) & 255, b = i >> 15;
          const float* src = P.cache_mem + ((((size_t)b * 256 + n) * 2 + kv) * 4 + h) * 128 + c8 * 8;
          const f32x4 a0 = __builtin_nontemporal_load((const f32x4*)src), a1 = __builtin_nontemporal_load((const f32x4*)(src + 4));
          v4u o; o.x = cvtpk(a0[0], a0[1]); o.y = cvtpk(a0[2], a0[3]); o.z = cvtpk(a1[0], a1[1]); o.w = cvtpk(a1[2], a1[3]);
          *(v4u*)(F.SMB() + ((((size_t)b * 4 + h) * 2 + kv) * 256 + n) * 128 + c8 * 8) = o; } }
    const int gt = F.vcu * NTHREADS + F.tid, NGT = F.G * NTHREADS;
    for (int i = gt; i < 2 * PB * 2 * 32 * 16; i += NGT) {
        const int kv = i / (PB * 2 * 32 * 16), r = i % (PB * 2 * 32 * 16), bg = r / 512, w = r % 512;
        ((v4u*)((kv ? F.VCP() : F.KCP()) + ((size_t)bg * 64 + 32) * 128))[w] = (v4u){0u, 0u, 0u, 0u};
    }
}

namespace att {
constexpr float SCALE = 0.08838834764831845f, C2 = 1.4426950408889634f * SCALE, THR = 8.f;
constexpr int SHM_T = 16384;
constexpr int L_SD = 65536, L_IMP = L_SD + 32768, L_MISC = 131072, L_WSF = L_MISC, L_LIST = L_WSF + 4096, L_RMASK = L_LIST + 1536, L_ML = L_RMASK + 2112, L_CTRL = L_ML + 2048, L_SDS = L_CTRL + 64, L_IMPS = L_SDS + 4096, L_END = L_IMPS + 1024;
static_assert(L_END <= LDS_BYTES - 128, "attention LDS map");
constexpr int SNT = 1;
constexpr int U_SNSA = SBATCH * 2 * (STOK / SNT), U_PNSA = PB * 2 * (PT / 64), U_PMEM = PB * 4 * (PT / 256), U_SMEM = SBATCH * 4, U_CONV = (MALL + 31) / 32, U_SROW = DM / 8;
constexpr int U0_PNSA = U_SNSA, U0_PMEM = U0_PNSA + U_PNSA, U0_SMEM = U0_PMEM + U_PMEM, U0_CONV = U0_SMEM + U_SMEM, U0_SROW = U0_CONV + U_CONV, U_TOTAL = U0_SROW + U_SROW;
constexpr unsigned N_SAMPLE_PRODUCERS = U_SNSA + U_SMEM + 1;

#define KSWZ(row, colB) ((row) * 256 + ((colB) ^ (((row) & 7) << 4)))
#define SBAR() __builtin_amdgcn_sched_barrier(0)
__device__ __forceinline__ int v_st(int k, int c) { const int kk = (k & ~0xC) | ((k & 4) << 1) | ((k & 8) >> 1); return ((kk >> 3) * 4 + (c >> 5)) * 512 + ((kk & 7) * 32 + (c & 31)) * 2; }
__device__ __forceinline__ int v_rd_base(int lane) { return ((lane & 3) << 3) | (((lane >> 2) & 3) << 6) | (((lane >> 4) & 1) << 5) | (((lane >> 5) & 1) << 8); }
constexpr int v_rd_off(int d0, int ks, int half) { return d0 * 512 + ks * 4096 + half * 2048; }
__device__ __forceinline__ int crow(int r, int hi) { return (r & 3) + 8 * (r >> 2) + 4 * hi; }
__device__ __forceinline__ bf16x8 pack8(f32x4 a, f32x4 b) { v4u w = {cvtpk(a[0], a[1]), cvtpk(a[2], a[3]), cvtpk(b[0], b[1]), cvtpk(b[2], b[3])}; return __builtin_bit_cast(bf16x8, w); }

__device__ __forceinline__ void mask_tile(f32x16& p0, f32x16& p1, bool rowok, int pos, int kpos0, int kstride, unsigned W, int hi) {
    const float NEG = -__builtin_inff();
    const int dq = pos - kpos0 - 4 * hi * kstride;
#pragma unroll
    for (int r = 0; r < 16; ++r) {
        const int c = (r & 3) + 8 * (r >> 2);
        if (!(rowok && (unsigned)(dq - c * kstride) < W)) p0[r] = NEG;
        if (!(rowok && (unsigned)(dq - (c + 32) * kstride) < W)) p1[r] = NEG;
    }
}
__device__ __forceinline__ void partialSM(f32x16& p0, f32x16& p1, float& m_reg, float& mn, float& alpha) {
    float pmax = p0[0];
#pragma unroll
    for (int r = 1; r < 16; ++r) pmax = fmaxf(pmax, p0[r]);
#pragma unroll
    for (int r = 0; r < 16; ++r) pmax = fmaxf(pmax, p1[r]);
    { auto rr = __builtin_amdgcn_permlane32_swap(__float_as_uint(pmax), __float_as_uint(pmax), false, false);
      pmax = fmaxf(__uint_as_float(rr[0]), __uint_as_float(rr[1])); }
    if (__builtin_expect(__all((pmax - m_reg) * SCALE <= THR), 1)) { mn = m_reg; alpha = 1.f; }
    else { mn = fmaxf(m_reg, pmax); alpha = __builtin_amdgcn_exp2f((m_reg - mn) * C2); m_reg = mn; }
    const float mnL = -mn * C2;
#pragma unroll
    for (int r = 0; r < 16; ++r) p0[r] = fmaf(p0[r], C2, mnL);
#pragma unroll
    for (int r = 0; r < 16; ++r) p1[r] = fmaf(p1[r], C2, mnL);
#pragma unroll
    for (int r = 0; r < 16; ++r) p0[r] = __builtin_amdgcn_exp2f(p0[r]);
}
__device__ __forceinline__ void finishSM(f32x16& p0, f32x16& p1, float alpha, float& l_reg, bf16x8& pa0, bf16x8& pa1, bf16x8& pa2, bf16x8& pa3) {
#pragma unroll
    for (int r = 0; r < 16; ++r) p1[r] = __builtin_amdgcn_exp2f(p1[r]);
    float ps = 0;
#pragma unroll
    for (int r = 0; r < 16; ++r) ps += p0[r];
#pragma unroll
    for (int r = 0; r < 16; ++r) ps += p1[r];
    { auto rr = __builtin_amdgcn_permlane32_swap(__float_as_uint(ps), __float_as_uint(ps), false, false);
      ps = __uint_as_float(rr[0]) + __uint_as_float(rr[1]); }
    l_reg = l_reg * alpha + ps;
#define PK4(P, B_, OUT) do { unsigned a0 = cvtpk(P[B_+0], P[B_+1]), a1 = cvtpk(P[B_+2], P[B_+3]);                          \
        unsigned b0 = cvtpk(P[B_+4], P[B_+5]), b1 = cvtpk(P[B_+6], P[B_+7]);                                             \
        auto r0 = __builtin_amdgcn_permlane32_swap(a0, b0, false, false); auto r1 = __builtin_amdgcn_permlane32_swap(a1, b1, false, false); \
        v4u w = {r0[0], r1[0], r0[1], r1[1]}; OUT = __builtin_bit_cast(bf16x8, w); } while (0)
    PK4(p0, 0, pa0); PK4(p0, 8, pa1); PK4(p1, 0, pa2); PK4(p1, 8, pa3);
#undef PK4
}
__device__ __forceinline__ void qkt(f32x16& p0, f32x16& p1, const lbyte* Kt, int r32, int hi, const bf16x8* qr) {
    p0 = f32x16{}; p1 = f32x16{};
    const lbyte* kb[4];
#pragma unroll
    for (int dd = 0; dd < 4; ++dd) kb[dd] = Kt + KSWZ(r32, (dd * 16 + hi * 8) * 2);
    bf16x8 fa0, fa1, fb0, fb1;
#define LDK(F0, F1, d0) do { const lbyte* a_ = kb[(d0) & 3] + ((d0) >> 2) * 128; F0 = *(const LAS bf16x8*)(a_); F1 = *(const LAS bf16x8*)(a_ + 32 * 256); } while (0)
#define MMK(F0, F1, d0) do { p0 = __builtin_amdgcn_mfma_f32_32x32x16_bf16(F0, qr[(d0)], p0, 0, 0, 0); p1 = __builtin_amdgcn_mfma_f32_32x32x16_bf16(F1, qr[(d0)], p1, 0, 0, 0); } while (0)
    LDK(fa0, fa1, 0); LDK(fb0, fb1, 1); SBAR();
    MMK(fa0, fa1, 0); SBAR(); LDK(fa0, fa1, 2); SBAR();
    MMK(fb0, fb1, 1); SBAR(); LDK(fb0, fb1, 3); SBAR();
    MMK(fa0, fa1, 2); SBAR(); LDK(fa0, fa1, 4); SBAR();
    MMK(fb0, fb1, 3); SBAR(); LDK(fb0, fb1, 5); SBAR();
    MMK(fa0, fa1, 4); SBAR(); LDK(fa0, fa1, 6); SBAR();
    MMK(fb0, fb1, 5); SBAR(); LDK(fb0, fb1, 7); SBAR();
    MMK(fa0, fa1, 6); MMK(fb0, fb1, 7);
#undef LDK
#undef MMK
}
__device__ __forceinline__ void pv_tile(f32x16* o, int vb, bf16x8 pa0, bf16x8 pa1, bf16x8 pa2, bf16x8 pa3) {
#define TRRD(dst, off) asm volatile("ds_read_b64_tr_b16 %0, %1 offset:%2" : "=&v"(dst) : "v"(vb), "i"(off) : "memory")
#define PV_D0(d0) do { s16x4 l0, l1, l2, l3, h0, h1, h2, h3; constexpr int b_ = v_rd_off(d0, 0, 0); \
        TRRD(l0, b_); TRRD(h0, b_ + 2048); TRRD(l1, b_ + 4096); TRRD(h1, b_ + 6144); TRRD(l2, b_ + 8192); TRRD(h2, b_ + 10240); TRRD(l3, b_ + 12288); TRRD(h3, b_ + 14336); \
        asm volatile("s_waitcnt lgkmcnt(0)" ::: "memory"); SBAR(); \
        o[d0] = __builtin_amdgcn_mfma_f32_32x32x16_bf16(pa0, (bf16x8){l0[0], l0[1], l0[2], l0[3], h0[0], h0[1], h0[2], h0[3]}, o[d0], 0, 0, 0);   \
        o[d0] = __builtin_amdgcn_mfma_f32_32x32x16_bf16(pa1, (bf16x8){l1[0], l1[1], l1[2], l1[3], h1[0], h1[1], h1[2], h1[3]}, o[d0], 0, 0, 0);   \
        o[d0] = __builtin_amdgcn_mfma_f32_32x32x16_bf16(pa2, (bf16x8){l2[0], l2[1], l2[2], l2[3], h2[0], h2[1], h2[2], h2[3]}, o[d0], 0, 0, 0);   \
        o[d0] = __builtin_amdgcn_mfma_f32_32x32x16_bf16(pa3, (bf16x8){l3[0], l3[1], l3[2], l3[3], h3[0], h3[1], h3[2], h3[3]}, o[d0], 0, 0, 0); } while (0)
    PV_D0(0); PV_D0(1); PV_D0(2); PV_D0(3);
#undef PV_D0
#undef TRRD
}

struct TileSrc { const char* kp; const char* vp; int strideB; int f32; int kpos0; int nvalid; unsigned mlo, mhi; };

__device__ __forceinline__ TileSrc tile_src(const Params& P, const Frame& F, int sample, int bk, int b, int gh, int j, int e, int su) {
    TileSrc s; s.nvalid = 64; s.f32 = 0; s.mlo = 0xffffffffu; s.mhi = 0xffffffffu;
    if (!sample) {
        if (bk == 0) { const size_t o = ((size_t)(b * 2 + gh) * 64) * 128 * 2; s.kp = (const char*)F.KCP() + o; s.vp = (const char*)F.VCP() + o; s.strideB = 256; s.kpos0 = 63; }
        else if (bk == 3) { const size_t o = (((size_t)b * 256 + j * 64) * 1024 + gh * 128) * 2; s.kp = (const char*)F.MKV() + o; s.vp = s.kp + 512 * 2; s.strideB = 2048; s.kpos0 = 0; }
        else { const int kind = bk == 1 ? 0 : 2; const size_t o = ((size_t)(kind * 8 + b * 2 + gh) * PT + j * 64) * 128 * 2;
               s.kp = (const char*)F.KV4() + o; s.vp = s.kp + (size_t)8 * PT * 128 * 2; s.strideB = 256; s.kpos0 = j * 64; }
    } else {
        if (bk == 0) { const size_t o = (((size_t)(b * 2 + gh) * 256 + j * 64) * 128) * 2; s.kp = (const char*)F.KCS() + o; s.vp = (const char*)F.VCS() + o; s.strideB = 256; s.kpos0 = j * 4096 + 63; }
        else if (bk == 3) { const size_t o = ((((size_t)b * 4 + gh) * 2) * 256 + j * 64) * 128 * 2; s.kp = (const char*)F.SMB() + o; s.vp = s.kp + (size_t)256 * 128 * 2; s.strideB = 256; s.kpos0 = 0; }
        else if (bk == 1 && j < 256) { const size_t o = ((size_t)su * 17 + e) * (2 * 64 * 128) * 2; s.kp = (const char*)F.SELS() + o; s.vp = s.kp + 64 * 128 * 2; s.strideB = 256; s.kpos0 = j * 64; }
        else if (bk == 2 && j < 8) { const size_t o = ((((size_t)b * 2 + gh) * 2) * 512 + j * 64) * 128 * 2; s.kp = (const char*)F.SWIN() + o; s.vp = s.kp + (size_t)512 * 128 * 2; s.strideB = 256; s.kpos0 = (PAST - 512) + j * 64; }
        else { const int part = bk == 1 ? 2 : 4; const size_t o = (((size_t)MP + b * 4) * ZLD + ZC_KV + part * 256 + gh * 128) * 2;
               s.kp = (const char*)F.Z() + o; s.vp = s.kp + 256 * 2; s.strideB = ZLD * 2; s.kpos0 = PAST; s.nvalid = 4; }
    }
    return s;
}

constexpr int SV_QS = 0, SV_S = 2048, SV_R = SV_S + 16384, SV_LM = SV_R + 32768, SV_CS = SV_LM + 64, SV_END = SV_CS + 2048;
__device__ __forceinline__ void sample_sel_valu(const Params& P, const Frame& F, int b, int g, int t, int n, lbyte* lds, int tid) {
    LAS float* const Qs = (LAS float*)(lds + SV_QS); LAS float* const S = (LAS float*)(lds + SV_S); LAS float* const R = (LAS float*)(lds + SV_R);
    LAS float* const LM = (LAS float*)(lds + SV_LM); LAS float* const CS = (LAS float*)(lds + SV_CS);
    LAS const int* const LISTc = (LAS const int*)(lds + L_LIST);
    asm volatile("" : "+v"(tid));
    const int row = MP + b * 4 + t, lane = tid & 63, wv = tid >> 6;
    { const int h = tid >> 7, d = tid & 127; Qs[h * 128 + d] = bf2f(F.Z()[(size_t)row * ZLD + ZC_Q + (g * 4 + h) * 128 + d]); }
    __syncthreads();
    { const int kk = tid >> 3, p8 = tid & 7;
      for (int e = 0; e < n; ++e) { const int j = __builtin_amdgcn_readfirstlane(LISTc[3 * e]);
          f32x4 kv[4];
          if (j < 256) { const int page = P.page_table[b * NPAGES + (j >> 1)];
              const float* kp = P.cache_kv + ((size_t)page * 128 + (j & 1) * 64 + kk) * 1024 + 2 * 256 + g * 128 + p8 * 16;
#pragma unroll
              for (int i = 0; i < 4; ++i) kv[i] = *(const f32x4*)(kp + 4 * i); }
          else { const bf16* kp = F.Z() + (size_t)(MP + b * 4 + (kk < 4 ? kk : 0)) * ZLD + ZC_KV + 2 * 256 + g * 128 + p8 * 16;
              const v4u w0 = *(const v4u*)kp, w1 = *(const v4u*)(kp + 8);
#pragma unroll
              for (int i = 0; i < 2; ++i) { kv[i] = (f32x4){__uint_as_float(w0[2 * i] << 16), __uint_as_float(w0[2 * i] & 0xffff0000u), __uint_as_float(w0[2 * i + 1] << 16), __uint_as_float(w0[2 * i + 1] & 0xffff0000u)};
                                            kv[2 + i] = (f32x4){__uint_as_float(w1[2 * i] << 16), __uint_as_float(w1[2 * i] & 0xffff0000u), __uint_as_float(w1[2 * i + 1] << 16), __uint_as_float(w1[2 * i + 1] & 0xffff0000u)}; } }
          float sc[4];
#pragma unroll
          for (int h = 0; h < 4; ++h) { const LAS f32x4* qh = (const LAS f32x4*)(Qs + h * 128 + p8 * 16); f32x4 a = qh[0] * kv[0] + qh[1] * kv[1] + qh[2] * kv[2] + qh[3] * kv[3]; float x = (a[0] + a[1]) + (a[2] + a[3]);
              x += __shfl_xor(x, 1); x += __shfl_xor(x, 2); x += __shfl_xor(x, 4); sc[h] = x; }
          if (p8 == 0) { const bool ok = j < 256 || kk <= t;
#pragma unroll
              for (int h = 0; h < 4; ++h) S[h * 1024 + e * 64 + kk] = ok ? sc[h] * SCALE : -__builtin_inff(); } } }
    __syncthreads();
    if (wv < 4) { const int NK = n * 64; LAS float* Sh = S + wv * 1024; float m = -__builtin_inff();
        for (int k = lane; k < NK; k += 64) m = fmaxf(m, Sh[k]);
#pragma unroll
        for (int o = 1; o < 64; o <<= 1) m = fmaxf(m, __shfl_xor(m, o));
        float l = 0.f;
        for (int k = lane; k < NK; k += 64) { const float p = __builtin_amdgcn_exp2f((Sh[k] - m) * 1.4426950408889634f); Sh[k] = p; l += p; }
        l = wave_sum(l); if (lane == 0) LM[wv] = l; }
    __syncthreads();
    { const int d4 = tid & 31, kg = tid >> 5;
      f32x4 acc[4];
#pragma unroll
      for (int h = 0; h < 4; ++h) acc[h] = (f32x4){0.f, 0.f, 0.f, 0.f};
      for (int e = 0; e < n; ++e) { const int j = __builtin_amdgcn_readfirstlane(LISTc[3 * e]);
          f32x4 vv[4];
          if (j < 256) { const int page = P.page_table[b * NPAGES + (j >> 1)];
              const float* vp = P.cache_kv + ((size_t)page * 128 + (j & 1) * 64 + kg) * 1024 + 3 * 256 + g * 128 + d4 * 4;
#pragma unroll
              for (int q = 0; q < 4; ++q) vv[q] = *(const f32x4*)(vp + (size_t)q * 16 * 1024); }
          else {
#pragma unroll
              for (int q = 0; q < 4; ++q) { const int key = kg + 16 * q; vv[q] = (f32x4){0.f, 0.f, 0.f, 0.f};
                  if (key < 4) { const v2u w = *(const v2u*)(F.Z() + (size_t)(MP + b * 4 + key) * ZLD + ZC_KV + 3 * 256 + g * 128 + d4 * 4);
                      vv[q] = (f32x4){__uint_as_float(w[0] << 16), __uint_as_float(w[0] & 0xffff0000u), __uint_as_float(w[1] << 16), __uint_as_float(w[1] & 0xffff0000u)}; } } }
#pragma unroll
          for (int q = 0; q < 4; ++q)
#pragma unroll
              for (int h = 0; h < 4; ++h) acc[h] += S[h * 1024 + e * 64 + kg + 16 * q] * vv[q]; }
#pragma unroll
      for (int h = 0; h < 4; ++h) *(LAS f32x4*)(R + (kg * 4 + h) * 128 + d4 * 4) = acc[h]; }
    __syncthreads();
    { const int h = tid >> 7, d = tid & 127; float o = 0.f;
#pragma unroll
      for (int kg = 0; kg < 16; ++kg) o += R[(kg * 4 + h) * 128 + d];
      const float gate = 1.0f / (1.0f + __expf(-bf2f(F.Z()[(size_t)row * ZLD + ZC_BG + (g * 4 + h) * 3 + 1])));
      CS[h * 128 + d] = gate * o / LM[h]; }
    __syncthreads();
}

__device__ __forceinline__ void attn_unit(const Params& P, const Frame& F0, int kind, int b, int gh, int t0, int nth, int nt) {
    Frame F = F0; asm volatile("" : "+s"(F.ws));
    int tid = F.wave * 64 + (int)__builtin_amdgcn_mbcnt_hi(~0u, __builtin_amdgcn_mbcnt_lo(~0u, 0u)); asm volatile("" : "+v"(tid));
    const int lane = tid & 63, wid = F.wave, r32 = lane & 31, hi = lane >> 5, w4 = wid & 3, half = wid >> 2;
    const bool nsa = kind < 2; const int sample = kind & 1;
    lbyte* const lds = F.lds;
    LAS float* const wsf = (LAS float*)(lds + L_WSF) + wid * 128;
    LAS int* const LIST = (LAS int*)(lds + L_LIST);
    LAS unsigned* const RMASK = (LAS unsigned*)(lds + L_RMASK);
    LAS float* const ML = (LAS float*)(lds + L_ML);
    LAS float* const IMP = (LAS float*)(lds + (sample ? L_IMPS : L_IMP));
    LAS float* const SD = (LAS float*)(lds + (sample ? L_SDS : L_SD));
    LAS int* const CTRL = (LAS int*)(lds + L_CTRL);
    unsigned totp[4][8];
#pragma unroll
    for (int d0 = 0; d0 < 4; ++d0)
#pragma unroll
        for (int q = 0; q < 8; ++q) totp[d0][q] = 0u;

    const int wrow0 = nsa ? half * nth : wid * 32;
    const int tokidx = wrow0 + r32;
    const bool valid = r32 < nth && tokidx < nt;
    const int su = (b * 2 + gh) * 4 + t0;
#define ROWOK(rw) ((rw) < nth && wrow0 + (rw) < nt)
    const int rowbase = sample ? MP + b * 4 + t0 : b * PT + t0;
    const int grow = rowbase + (valid ? tokidx : 0);
    const int pos = (sample ? PAST + t0 : t0) + tokidx;
    const int head = nsa ? gh * 4 + w4 : gh;
    const int qcol = nsa ? ZC_Q + head * 128 : ZC_MQ + head * 128;
    const int g2col = nsa ? ZC_NG + head * 128 : ZC_MG + head * 128;
    const int mixcol = nsa ? 512 + head * 128 : 1536 + head * 128;
    const int cur = sample ? 256 : (t0 >> 6);
    const unsigned vmask = nth >= 32 ? 0xffffffffu : ((1u << nth) - 1u);
    const bool allvalid = nth >= 32 && wrow0 + 32 <= nt;

#define PT0(id) unsigned long long pt0_##id = 0; if (PROBE_PHASE == (id) && sample) pt0_##id = __builtin_amdgcn_s_memrealtime()
#define PT1(id) do { if (PROBE_PHASE == (id) && sample && threadIdx.x == 0) { volatile LAS unsigned long long* tacc = (volatile LAS unsigned long long*)(lds + LDS_BYTES - 128 + 16) + 7; *tacc = *tacc + (__builtin_amdgcn_s_memrealtime() - pt0_##id); } } while (0)
    unsigned long long pq0_ = 0; if (PROBE_PHASE == 64 && kind == 0) pq0_ = __builtin_amdgcn_s_memrealtime();
    bf16x8 qr[8];
    { const bf16* qp = F.Z() + (size_t)grow * ZLD + qcol + hi * 8;
#pragma unroll
      for (int d0 = 0; d0 < 8; ++d0) qr[d0] = *(const bf16x8*)(qp + d0 * 16); }
    if (PROBE_PHASE == 64 && kind == 0) { asm volatile("s_waitcnt vmcnt(0)" ::: "memory"); if (threadIdx.x == 0) { volatile LAS unsigned long long* tacc = (volatile LAS unsigned long long*)(lds + LDS_BYTES - 128 + 16) + 7; *tacc = *tacc + (__builtin_amdgcn_s_memrealtime() - pq0_); } }

    if (kind == 1) {
        const v4u* w0 = (const v4u*)(F.KCS() + (size_t)(b * 2 + gh) * 256 * 128); const v4u* w1 = (const v4u*)(F.VCS() + (size_t)(b * 2 + gh) * 256 * 128);
        const v4u* w2 = (const v4u*)(F.SWIN() + (size_t)(b * 2 + gh) * 2 * 512 * 128);
        v4u acc_ = (v4u){0u, 0u, 0u, 0u};
#pragma unroll
        for (int i = 0; i < 8; ++i) { acc_ |= w0[tid + 512 * i]; acc_ |= w1[tid + 512 * i]; }
#pragma unroll 8
        for (int i = 0; i < 32; ++i) acc_ |= w2[tid + 512 * i];
        asm volatile("" :: "v"(acc_));
    }
    const int nbr = nsa ? 3 : 1;
    for (int br = 0; br < nbr; ++br) {
        const int bk = nsa ? br : 3;
        int ntiles, jlo = 0, listmode = 0, kstride = 1; unsigned W = 0x7fffffffu;
        if (bk == 0) { ntiles = sample ? 4 : 1; kstride = 64; }
        else if (bk == 1) { ntiles = CTRL[1]; listmode = 1; }
        else if (bk == 2) { W = 512u; if (sample) { ntiles = 9; } else { const int lo = t0 - 511; jlo = lo > 0 ? (lo >> 6) : 0; ntiles = ((t0 + nt - 1) >> 6) - jlo + 1; } }
        else { ntiles = 4; kstride = 0; }
        ntiles = __builtin_amdgcn_readfirstlane(ntiles);
        if (nsa && bk <= 1) {
            if (bk == 0) { const bf16* qp = F.QNR() + ((size_t)grow * 8 + head) * 32 + hi * 8; qr[0] = *(const bf16x8*)qp; qr[1] = *(const bf16x8*)(qp + 16); }
            else { const bf16* qp = F.Z() + (size_t)grow * ZLD + qcol + hi * 8; qr[0] = *(const bf16x8*)qp; qr[1] = *(const bf16x8*)(qp + 16); }
        }
        if (sample && bk == 1) continue;
        const float gate = nsa ? 1.0f / (1.0f + __expf(-bf2f(F.Z()[(size_t)grow * ZLD + ZC_BG + head * 3 + br]))) : 1.0f;
        const bool dump = nsa && bk == 0;
        const int dumpNK = sample ? 256 : 32;

        float m_reg = -1e30f, l_reg = 0.f; f32x16 o[4];
#pragma unroll
        for (int d0 = 0; d0 < 4; ++d0) o[d0] = f32x16{};

#define GET_ENTRY(e, J, ML_, MH_) do { if (listmode) { J = __builtin_amdgcn_readfirstlane(LIST[3 * (e)]); ML_ = (unsigned)__builtin_amdgcn_readfirstlane(LIST[3 * (e) + 1]); MH_ = (unsigned)__builtin_amdgcn_readfirstlane(LIST[3 * (e) + 2]); } else { J = jlo + (e); ML_ = 0xffffffffu; MH_ = 0xffffffffu; } } while (0)
#define STAGE_DMA(S_, bf) do { lbyte* Kt_ = lds + (bf) * (2 * SHM_T); lbyte* Vt_ = Kt_ + SHM_T; int l_ = lane; asm volatile("" : "+v"(l_));   \
        const int dk_row = l_ >> 4, dk_c0 = (l_ & 15) ^ (l_ >> 4), dv_kk = (l_ & 31) >> 2, dv_c = (l_ & 3) * 8; \
        _Pragma("unroll") for (int i_ = 0; i_ < 2; ++i_) { const int q_ = wid * 2 + i_; \
            __builtin_amdgcn_global_load_lds((const unsigned*)((S_).kp + (size_t)(q_ * 4 + dk_row) * (S_).strideB + ((dk_c0 ^ ((i_ & 1) << 2)) * 16)), (LAS unsigned*)(Kt_ + q_ * 1024), 16, 0, 0); \
            const int st_ = 2 * q_ + (l_ >> 5); const int kk_ = (st_ >> 2) * 8 + dv_kk; const int k_ = (kk_ & ~0xC) | ((kk_ & 4) << 1) | ((kk_ & 8) >> 1); \
            __builtin_amdgcn_global_load_lds((const unsigned*)((S_).vp + (size_t)k_ * (S_).strideB + ((st_ & 3) * 32 + dv_c) * 2), (LAS unsigned*)(Vt_ + q_ * 1024), 16, 0, 0); } } while (0)
#define STAGE_PART(S_, bf) do { lbyte* Kt_ = lds + (bf) * (2 * SHM_T); lbyte* Vt_ = Kt_ + SHM_T; int t_ = tid; asm volatile("" : "+v"(t_)); const int sr = t_ >> 4, sc = (t_ & 15) * 8; \
        _Pragma("unroll") for (int i_ = 0; i_ < 2; ++i_) { const int row_ = sr + 32 * i_; bf16x8 k_ = bf16x8{}, v_ = bf16x8{}; \
            if (row_ < (S_).nvalid) { k_ = *(const bf16x8*)((S_).kp + (size_t)row_ * (S_).strideB + sc * 2); v_ = *(const bf16x8*)((S_).vp + (size_t)row_ * (S_).strideB + sc * 2); } \
            *(LAS bf16x8*)(Kt_ + KSWZ(row_, sc * 2)) = k_; *(LAS bf16x8*)(Vt_ + v_st(row_, sc)) = v_; } } while (0)
#define IS_DMA(S_) ((S_).nvalid == 64)
#define EMPTY_SRC(S_) do { (S_).kpos0 = 0; (S_).mlo = 0u; (S_).mhi = 0u; (S_).f32 = 0; (S_).nvalid = 64; (S_).kp = nullptr; (S_).vp = nullptr; (S_).strideB = 0; } while (0)
#define FETCH_SRC(S_, e_) do { int j_; unsigned ml_, mh_; GET_ENTRY((e_), j_, ml_, mh_); (S_) = tile_src(P, F, sample, bk, b, gh, j_, (e_), su); (S_).mlo = ml_; (S_).mhi = mh_; } while (0)
        TileSrc cs0, cs1; EMPTY_SRC(cs0); EMPTY_SRC(cs1);
        if (ntiles > 0) { FETCH_SRC(cs0, 0); if (IS_DMA(cs0)) { STAGE_DMA(cs0, 0); } else { STAGE_PART(cs0, 0); } }
        if (ntiles > 1) { FETCH_SRC(cs1, 1); if (IS_DMA(cs1)) { STAGE_DMA(cs1, 1); } else { STAGE_PART(cs1, 1); } }
        asm volatile("s_waitcnt vmcnt(0)" ::: "memory");
        __syncthreads();
        unsigned long long tl0_ = 0; if (PROBE_PHASE == 10) tl0_ = __builtin_amdgcn_s_memrealtime();
        PT0(40);
        const int nsteps = (ntiles + 1) >> 1;
        for (int s2 = 0; s2 < nsteps; ++s2) {
            const int base = 2 * s2, bb = (s2 & 1) * 2, nb = 2 - bb;
            const bool h0 = base + 2 < ntiles, h1 = base + 3 < ntiles;
            TileSrc ns0, ns1; EMPTY_SRC(ns0); EMPTY_SRC(ns1);
#define NEXT_TILES() do { if (h0) { FETCH_SRC(ns0, base + 2); if (IS_DMA(ns0)) { STAGE_DMA(ns0, nb); } } if (h1) { FETCH_SRC(ns1, base + 3); if (IS_DMA(ns1)) { STAGE_DMA(ns1, nb + 1); } } } while (0)
#define COMPUTE_TILE(C_, BUF_, AFTER_QK) do { \
                const lbyte* Kt = lds + (BUF_) * (2 * SHM_T); \
                f32x16 p0, p1; float mn, alpha; bf16x8 pa0, pa1, pa2, pa3; \
                qkt(p0, p1, Kt, r32, hi, qr); \
                SBAR(); AFTER_QK; SBAR(); \
                { const unsigned rm = half ? (C_).mhi : (C_).mlo; const unsigned rmm = nsa ? rm : 0xffffffffu; \
                  const int pmin = (sample ? PAST + t0 : t0) + wrow0, kmax = (C_).kpos0 + 63 * kstride; \
                  const bool full = allvalid && rmm == 0xffffffffu && kmax <= pmin && (long long)(C_).kpos0 > (long long)pmin + 31 - (long long)W; \
                  if (!full) mask_tile(p0, p1, valid && ((rmm >> (r32 & 31)) & 1u), pos, (C_).kpos0, kstride, W, hi); } \
                if (dump && valid) { const int key0 = (sample ? (((C_).kpos0 - 63) >> 6) : 0); \
                    _Pragma("unroll") for (int r = 0; r < 16; ++r) { const int kk = key0 + crow(r, hi); \
                        if (kk < dumpNK) SD[(w4 * nt + tokidx) * dumpNK + kk] = p0[r]; \
                        if (kk + 32 < dumpNK) SD[(w4 * nt + tokidx) * dumpNK + kk + 32] = p1[r]; } } \
                partialSM(p0, p1, m_reg, mn, alpha); \
                finishSM(p0, p1, alpha, l_reg, pa0, pa1, pa2, pa3); \
                if (__any(alpha < 1.f)) { if (hi == 0) wsf[r32] = alpha; LDS_WAIT(); \
                    _Pragma("unroll") for (int r = 0; r < 16; ++r) { const float a = wsf[crow(r, hi)]; \
                        _Pragma("unroll") for (int d0 = 0; d0 < 4; ++d0) o[d0][r] *= a; } } \
                { int lv_ = lane; asm volatile("" : "+v"(lv_)); pv_tile(o, (int)(unsigned)(uintptr_t)(Kt + SHM_T) + v_rd_base(lv_), pa0, pa1, pa2, pa3); } } while (0)
            if (wrow0 < nt) {
                COMPUTE_TILE(cs0, bb, NEXT_TILES());
                if (base + 1 < ntiles) { COMPUTE_TILE(cs1, bb + 1, (void)0); }
            }
            else { NEXT_TILES(); }
#undef NEXT_TILES
#undef COMPUTE_TILE
            if (h0 && !IS_DMA(ns0)) { STAGE_PART(ns0, nb); }
            if (h1 && !IS_DMA(ns1)) { STAGE_PART(ns1, nb + 1); }
            cs0 = ns0; cs1 = ns1;
            asm volatile("s_waitcnt vmcnt(0)" ::: "memory");
            __syncthreads();
        }
#undef EMPTY_SRC
#undef FETCH_SRC
        if ((PROBE_PHASE == 10 || PROBE_PHASE == 13) && threadIdx.x == 0) { volatile LAS unsigned long long* tacc = (volatile LAS unsigned long long*)(lds + LDS_BYTES - 128 + 16) + 7; *tacc = *tacc + (PROBE_PHASE == 10 ? (__builtin_amdgcn_s_memrealtime() - tl0_) : (unsigned long long)ntiles * 100ull); }
        PT1(40);
#undef GET_ENTRY
#undef STAGE_DMA
#undef STAGE_PART
#undef IS_DMA
        const float inv = l_reg > 0.f ? 1.0f / l_reg : 0.f;
        if (dump) {
            PT0(42);
            if (hi == 0 && valid) { ML[(w4 * nt + tokidx) * 2] = m_reg; ML[(w4 * nt + tokidx) * 2 + 1] = inv; }
            __syncthreads();
            const int total = nt * dumpNK;
            for (int idx = tid; idx < total; idx += NTHREADS) { const int t = idx / dumpNK, j = idx - t * dumpNK; float sacc = 0.f;
#pragma unroll
                for (int w = 0; w < 4; ++w) { const float sc_ = SD[(w * nt + t) * dumpNK + j]; sacc += __builtin_amdgcn_exp2f((sc_ - ML[(w * nt + t) * 2]) * C2) * ML[(w * nt + t) * 2 + 1]; }
                IMP[idx] = sacc; }
            for (int j = tid; j < 2 * 264; j += NTHREADS) { const int jj = j >= 264 ? j - 264 : j; RMASK[j] = (jj <= cur && (jj == 0 || jj == cur || jj == cur - 1)) ? vmask : 0u; }
            __syncthreads();
            const int nforced = cur == 0 ? 1 : (cur == 1 ? 2 : 3), ksel = 16 - nforced;
            for (int idx = tid; idx < total; idx += NTHREADS) { const int t = idx / dumpNK, j = idx - t * dumpNK;
                if (j >= 1 && j <= cur - 2) { const float v = IMP[idx]; int rank = 0;
                    for (int i4 = 0; i4 <= cur - 2; i4 += 4) { const f32x4 x = *(const LAS f32x4*)(IMP + t * dumpNK + i4);
#pragma unroll
                        for (int e = 0; e < 4; ++e) { const int i = i4 + e; rank += (i >= 1 && i <= cur - 2 && (x[e] > v || (x[e] == v && i < j))) ? 1 : 0; } }
                    if (rank < ksel) __hip_atomic_fetch_or(&RMASK[(t / nth) * 264 + j], 1u << (t % nth), __ATOMIC_RELAXED, __HIP_MEMORY_SCOPE_WORKGROUP); } }
            __syncthreads();
            if (wid == 0) { int n = 0;
                for (int base = 0; base <= cur; base += 64) { const int j = base + lane; const unsigned rl = j <= cur ? RMASK[j] : 0u, rh = j <= cur ? RMASK[264 + j] : 0u; const bool has = (rl | rh) != 0u;
                    const unsigned long long bal = __ballot(has);
                    if (has) { const int ix = n + __popcll(bal & ((1ull << lane) - 1ull)); LIST[3 * ix] = j; LIST[3 * ix + 1] = (int)rl; LIST[3 * ix + 2] = (int)rh; }
                    n += __popcll(bal); }
                if (lane == 0) CTRL[1] = n; }
            __syncthreads();
            PT1(42);
        }
        if (hi == 0) wsf[r32] = gate * inv;
        LDS_WAIT();
        {
#pragma unroll
        for (int q = 0; q < 8; ++q) { const float c0 = wsf[crow(2 * q, hi)], c1 = wsf[crow(2 * q + 1, hi)];
#pragma unroll
            for (int d0 = 0; d0 < 4; ++d0) { float v0 = c0 * o[d0][2 * q], v1 = c1 * o[d0][2 * q + 1];
                { const unsigned tp = totp[d0][q]; v0 += __uint_as_float(tp << 16); v1 += __uint_as_float(tp & 0xffff0000u); }
                totp[d0][q] = cvtpk(v0, v1); } } }
    if (dump && sample) {
            sample_sel_valu(P, F, b, gh, t0, CTRL[1], lds, tid);
            if (half == 0 && hi == 0) { const LAS float* CSp = (const LAS float*)(lds + SV_CS) + w4 * 128 + r32;
#pragma unroll
                for (int d0 = 0; d0 < 4; ++d0) { const unsigned tp = totp[d0][0]; totp[d0][0] = cvtpk(__uint_as_float(tp << 16) + CSp[d0 * 32], __uint_as_float(tp & 0xffff0000u)); } }
            __syncthreads();
        }
    }
    {
        const bf16* gp = F.Z() + (size_t)rowbase * ZLD + g2col + r32;
        unsigned short gv[16][4];
#pragma unroll
        for (int r = 0; r < 16; ++r) { const int ti = wrow0 + crow(r, hi); const size_t ro = (size_t)(ROWOK(crow(r, hi)) ? ti : 0) * ZLD;
#pragma unroll
            for (int d0 = 0; d0 < 4; ++d0) gv[r][d0] = gp[ro + d0 * 32]; }
#pragma unroll
        for (int r = 0; r < 16; ++r) { const int ti = wrow0 + crow(r, hi); const bool ok = ROWOK(crow(r, hi));
            bf16* mp = F.MIX() + (size_t)(rowbase + (ok ? ti : 0)) * DM + mixcol + r32;
#pragma unroll
            for (int d0 = 0; d0 < 4; ++d0) { const float gt = bf2f(gv[r][d0]);
                const unsigned tp = totp[d0][r >> 1]; const float tv = (r & 1) ? __uint_as_float(tp & 0xffff0000u) : __uint_as_float(tp << 16);
                const float v = tv * (gt / (1.0f + __expf(-gt)));
                const float vn = __shfl_xor(v, 1);
                if (ok && (r32 & 1) == 0) *(unsigned*)(mp + d0 * 32) = cvtpk(v, vn); } }
    }
    __syncthreads();
#undef ROWOK
}
#undef KSWZ
#undef SBAR

__device__ __forceinline__ void conv_unit(const Params& P, const Frame& F0, int cu) {
    Frame F = F0; asm volatile("" : "+s"(F.ws));
    int tid = F.wave * 64 + (int)__builtin_amdgcn_mbcnt_hi(~0u, __builtin_amdgcn_mbcnt_lo(~0u, 0u)); asm volatile("" : "+v"(tid));
    const int r0 = cu * 32;
    for (int it = tid; it < 32 * 64; it += NTHREADS) {
        const int row = r0 + (it >> 6), c = (it & 63) * 8;
        if (row >= MALL) continue;
        const bool smp = row >= MP; const int t = smp ? ((row - MP) & 3) : (row & (PT - 1)); const int bs = smp ? ((row - MP) >> 2) : 0;
        const bf16* z = F.Z() + (size_t)row * ZLD;
        float u[3][8];
#pragma unroll
        for (int k = 0; k < 3; ++k) { const int tt = t - 2 + k;
            if (tt >= 0) { const bf16* zz = z - (size_t)(2 - k) * ZLD; const v4u cc = *(const v4u*)(zz + ZC_CC + c), ch = *(const v4u*)(zz + ZC_CH + c);
#pragma unroll
                for (int i = 0; i < 4; ++i) { u[k][2 * i] = __uint_as_float(cc[i] << 16) * __uint_as_float(ch[i] << 16); u[k][2 * i + 1] = __uint_as_float(cc[i] & 0xffff0000u) * __uint_as_float(ch[i] & 0xffff0000u); } }
            else if (smp) { const float* sp = P.state_conv + ((size_t)bs * 2 + (2 + tt)) * 512 + c; const f32x4 a0 = *(const f32x4*)sp, a1 = *(const f32x4*)(sp + 4);
#pragma unroll
                for (int i = 0; i < 4; ++i) { u[k][i] = a0[i]; u[k][4 + i] = a1[i]; } }
            else {
#pragma unroll
                for (int i = 0; i < 8; ++i) u[k][i] = 0.f; } }
        const v4u cb = *(const v4u*)(z + ZC_CB + c), cg = *(const v4u*)(z + ZC_CG + c);
        float w[3][8];
#pragma unroll
        for (int k = 0; k < 3; ++k) { const f32x4 a0 = *(const f32x4*)(P.w_conv + k * 512 + c), a1 = *(const f32x4*)(P.w_conv + k * 512 + c + 4);
#pragma unroll
            for (int i = 0; i < 4; ++i) { w[k][i] = a0[i]; w[k][4 + i] = a1[i]; } }
        float v[8];
#pragma unroll
        for (int i = 0; i < 8; ++i) { const float y = w[0][i] * u[0][i] + w[1][i] * u[1][i] + w[2][i] * u[2][i];
            const unsigned gw = cg[i >> 1], bw = cb[i >> 1]; const float gt = (i & 1) ? __uint_as_float(gw & 0xffff0000u) : __uint_as_float(gw << 16), bb = (i & 1) ? __uint_as_float(bw & 0xffff0000u) : __uint_as_float(bw << 16);
            v[i] = (gt / (1.0f + __expf(-gt))) * (bb * y); }
        v4u o; o.x = cvtpk(v[0], v[1]); o.y = cvtpk(v[2], v[3]); o.z = cvtpk(v[4], v[5]); o.w = cvtpk(v[6], v[7]);
        *(v4u*)(F.MIX() + (size_t)row * DM + c) = o;
        float* op = nullptr;
        if (!smp) { if (t >= PT - 2) op = P.out + OFF_CONVP + ((size_t)(row >> 11) * 2 + (t - (PT - 2))) * 512 + c; }
        else if (t >= 2) op = P.out + OFF_CONVS + ((size_t)bs * 2 + (t - 2)) * 512 + c;
        if (op) { *(f32x4*)op = (f32x4){u[2][0], u[2][1], u[2][2], u[2][3]}; *(f32x4*)(op + 4) = (f32x4){u[2][4], u[2][5], u[2][6], u[2][7]}; }
    }
}

__device__ __forceinline__ void sample_rows_published(const Frame& F) {
    asm volatile("s_waitcnt vmcnt(0)" ::: "memory"); __syncthreads();
    if (threadIdx.x == 0) { __builtin_amdgcn_fence(__ATOMIC_RELEASE, "agent"); asm volatile("s_waitcnt vmcnt(0)" ::: "memory");
        __hip_atomic_fetch_add(F.QUEUE() + 64 * 12, 1u, __ATOMIC_RELAXED, __HIP_MEMORY_SCOPE_AGENT); }
}
__device__ __forceinline__ void srow_unit(const Params& P, const Frame& F0, int cb) {
    Frame F = F0; asm volatile("" : "+s"(F.ws));
    int tid = F.wave * 64 + (int)__builtin_amdgcn_mbcnt_hi(~0u, __builtin_amdgcn_mbcnt_lo(~0u, 0u)); asm volatile("" : "+v"(tid));
    const int lane = tid & 63;
    if (tid == 0) { unsigned sp = 0; while (__hip_atomic_load(F.QUEUE() + 64 * 12, __ATOMIC_RELAXED, __HIP_MEMORY_SCOPE_AGENT) < N_SAMPLE_PRODUCERS) { __builtin_amdgcn_s_sleep(8); if (++sp > (1u << 20)) break; }
        __builtin_amdgcn_fence(__ATOMIC_ACQUIRE, "agent"); asm volatile("s_waitcnt vmcnt(0)" ::: "memory"); }
    __syncthreads();
    float* const sss = F.SSP() + (size_t)MP * 32;
    { const v4u* src = (const v4u*)(F.MIX() + (size_t)MP * DM); LAS v4u* dst = (LAS v4u*)F.lds;
#pragma unroll 4
      for (int i = 0; i < 16; ++i) dst[tid + 512 * i] = src[tid + 512 * i]; }
    __syncthreads();
    const int col = cb * 8 + F.wave;
    v4u wv[4]; { const v4u* w = (const v4u*)(F.WoutT() + (size_t)col * DM) + lane * 4;
#pragma unroll
      for (int j = 0; j < 4; ++j) wv[j] = w[j]; }
    float mine = 0.f;
    for (int row = 0; row < 32; ++row) { const LAS v4u* a = (const LAS v4u*)F.lds + row * 256 + lane * 4; float s = 0.f;
#pragma unroll
        for (int j = 0; j < 4; ++j) { const v4u av = a[j];
#pragma unroll
            for (int e = 0; e < 4; ++e) { s += __uint_as_float(av[e] << 16) * __uint_as_float(wv[j][e] << 16); s += __uint_as_float(av[e] & 0xffff0000u) * __uint_as_float(wv[j][e] & 0xffff0000u); } }
        s = wave_sum(s); if (lane == row) mine = s; }
    LAS float* sq = (LAS float*)(F.lds + 131072);
    if (lane < 32) { const float v = mine + P.x_sample[(size_t)lane * DM + col]; P.out[OFF_YS + (size_t)lane * DM + col] = v; sq[F.wave * 32 + lane] = v * v; }
    __syncthreads();
    if (tid < 32) { float q = 0.f;
#pragma unroll
        for (int w = 0; w < 8; ++w) q += sq[w * 32 + tid];
        sss[(size_t)tid * 256 + cb] = q; }
    __syncthreads();
}

__device__ __forceinline__ void p3_attention(const Params& P, const Frame& F, unsigned xcc) {
    int stage = 0, probe = 0, pending = -1;
    for (;;) {
        int u;
        if (pending >= 0) { u = pending; pending = -1; }
        else {
            int ctl_off = L_CTRL; asm volatile("" : "+v"(ctl_off));
            LAS int* const CTRL = (LAS int*)(F.lds + ctl_off);
            const int qi = stage == 0 ? 0 : (stage == 1 ? 1 + (int)((xcc + (unsigned)probe) & 7u) : 9);
            if (F.wave == 0 && __builtin_amdgcn_mbcnt_hi(~0u, __builtin_amdgcn_mbcnt_lo(~0u, 0u)) == 0u) CTRL[0] = (int)atomicAdd(F.QUEUE() + 64 * qi, 1u);
            __syncthreads();
            const int v = __builtin_amdgcn_readfirstlane(CTRL[0]);
            __syncthreads();
            if (stage == 0) { if (v >= U_SNSA) { stage = 1; continue; } u = v; }
            else if (stage == 1) { if (v >= 24) { if (++probe >= 8) stage = 2; continue; }
                if (v < 16) u = U0_PNSA + v * 8 + (qi - 1);
                else { const int p = v - 16; u = U0_PNSA + (16 + p) * 8 + (qi - 1); pending = U0_PNSA + (31 - p) * 8 + (qi - 1); } }
            else { if (v >= U_TOTAL - U0_PMEM) break; u = U0_PMEM + v; }
        }
        unsigned long long tu0_ = 0; if (PROBE_PHASE >= 20) tu0_ = __builtin_amdgcn_s_memrealtime();
        const int ukind_ = u < U0_PNSA ? 0 : (u < U0_PMEM ? 1 : (u < U0_SMEM ? 2 : (u < U0_CONV ? 3 : 4)));
#define UNIT_DONE() do { if (PROBE_PHASE >= 50 && PROBE_PHASE - 50 == ukind_ && threadIdx.x == 0) { volatile LAS unsigned long long* ts_ = (volatile LAS unsigned long long*)(F.lds + LDS_BYTES - 128 + 16); ts_[7] = __builtin_amdgcn_s_memrealtime() - ts_[3]; } if (PROBE_PHASE >= 20 && PROBE_PHASE < 50 && PROBE_PHASE - 20 == ukind_ && threadIdx.x == 0) { volatile LAS unsigned long long* tacc = (volatile LAS unsigned long long*)(F.lds + LDS_BYTES - 128 + 16) + 7; *tacc = *tacc + (__builtin_amdgcn_s_memrealtime() - tu0_); } } while (0)
        if (u >= U0_SROW) { srow_unit(P, F, u - U0_SROW); UNIT_DONE(); continue; }
        if (u >= U0_CONV) { conv_unit(P, F, u - U0_CONV); if (u - U0_CONV == MP / 32) sample_rows_published(F); UNIT_DONE(); continue; }
        int kind, b, gh, t0, nth, nt;
        if (u < U0_PNSA) { const int per = STOK / SNT; const int bg = u / per, tt = u % per; kind = 1; b = bg >> 1; gh = bg & 1; t0 = tt * SNT; nth = 1; nt = 1; }
        else if (u < U0_PMEM) { const int w = u - U0_PNSA; const int qt = 31 - (w >> 3), bg = w & 7; kind = 0; b = bg >> 1; gh = bg & 1; t0 = qt * 64; nth = 32; nt = 64; }
        else if (u < U0_SMEM) { const int w = u - U0_PMEM; const int qt = w >> 4, bh = w & 15; kind = 2; b = bh >> 2; gh = bh & 3; t0 = qt * 256; nth = 32; nt = 256; }
        else { const int w = u - U0_SMEM; kind = 3; b = w >> 2; gh = w & 3; t0 = 0; nth = 4; nt = 4; }
        attn_unit(P, F, kind, b, gh, t0, nth, nt);
        if (kind & 1) sample_rows_published(F);
        UNIT_DONE();
    }
}
}

__device__ __forceinline__ void p4_sample_rows(const Params& P, Frame& F) {
    float* const sss = F.SSP() + (size_t)MP * 32;
    for (int cb = F.vcu; cb < DM / 8; cb += F.G) {
        { const v4u* src = (const v4u*)(F.MIX() + (size_t)MP * DM); LAS v4u* dst = (LAS v4u*)F.lds;
#pragma unroll 4
          for (int i = 0; i < 16; ++i) dst[F.tid + 512 * i] = src[F.tid + 512 * i]; }
        __syncthreads();
        const int col = cb * 8 + F.wave;
        v4u wv[4]; { const v4u* w = (const v4u*)(F.WoutT() + (size_t)col * DM) + F.lane * 4;
#pragma unroll
          for (int j = 0; j < 4; ++j) wv[j] = w[j]; }
        float mine = 0.f;
        for (int row = 0; row < 32; ++row) { const LAS v4u* a = (const LAS v4u*)F.lds + row * 256 + F.lane * 4; float s = 0.f;
#pragma unroll
            for (int j = 0; j < 4; ++j) { const v4u av = a[j];
#pragma unroll
                for (int e = 0; e < 4; ++e) { s += __uint_as_float(av[e] << 16) * __uint_as_float(wv[j][e] << 16); s += __uint_as_float(av[e] & 0xffff0000u) * __uint_as_float(wv[j][e] & 0xffff0000u); } }
            s = wave_sum(s); if (F.lane == row) mine = s; }
        LAS float* sq = (LAS float*)(F.lds + 131072);
        if (F.lane < 32) { const float v = mine + P.x_sample[(size_t)F.lane * DM + col]; P.out[OFF_YS + (size_t)F.lane * DM + col] = v; sq[F.wave * 32 + F.lane] = v * v; }
        __syncthreads();
        if (F.tid < 32) { float q = 0.f;
#pragma unroll
            for (int w = 0; w < 8; ++w) q += sq[w * 32 + F.tid];
            sss[(size_t)F.tid * 256 + cb] = q; }
        __syncthreads();
    }
}

__device__ __forceinline__ void p5_final_norm(const Params& P, Frame& F, int first_row) {
    const int gw = F.vcu * NWAVES + F.wave, NGW = F.G * NWAVES;
    for (int m = first_row + gw; m < MALL; m += NGW) {
        float* row = m < MP ? P.out + OFF_YP + (size_t)m * DM : P.out + OFF_YS + (size_t)(m - MP) * DM;
        float ss;
        if (m < MP) { ss = F.lane < 32 ? F.SSP()[(size_t)m * 32 + F.lane] : 0.f; }
        else { const float* sp = F.SSP() + (size_t)MP * 32 + (size_t)(m - MP) * 256; ss = (sp[F.lane] + sp[64 + F.lane]) + (sp[128 + F.lane] + sp[192 + F.lane]); }
        const float rstd = 1.0f / sqrtf(wave_sum(ss) * (1.f / DM) + NORM_EPS);
        f32x4* xr = (f32x4*)row + F.lane; const f32x4* gr = (const f32x4*)P.final_g + F.lane;
#pragma unroll
        for (int j = 0; j < 8; ++j) { f32x4 v = xr[64 * j]; const f32x4 g = gr[64 * j]; v = v * rstd * g; xr[64 * j] = v; }
    }
}

#define RLX_AGENT __ATOMIC_RELAXED, __HIP_MEMORY_SCOPE_AGENT
#define XB_TMO      128
#define XB_XCNT(j)  (256  + 64 * (j))
#define XB_XSUB(j)  (1280 + 64 * (j))
#define XB_XGEN(j)  (2304 + 64 * (j))
#define XB_TOP      3328
#define XB_TOPGEN   3392
#define XCD_BAR_WORDS 3456
#define XB_SPIN_CAP (1u << 18)

__device__ __forceinline__ unsigned xb_ld(unsigned* p)              { return __hip_atomic_load(p, __ATOMIC_RELAXED, __HIP_MEMORY_SCOPE_AGENT); }
__device__ __forceinline__ unsigned xb_add(unsigned* p, unsigned v) { return __hip_atomic_fetch_add(p, v, __ATOMIC_RELAXED, __HIP_MEMORY_SCOPE_AGENT); }
__device__ __forceinline__ unsigned xb_xcc_id() { return (unsigned)__builtin_amdgcn_s_getreg((3 << 11) | 20) & 0xFu; }
#define XB_SPIN(cond, bar) do { unsigned _sp = 0; while (cond) { __builtin_amdgcn_s_sleep(1); \
    if ((++_sp & 255u) == 0u) { if (xb_ld(&(bar)[XB_TMO])) break; if (_sp > XB_SPIN_CAP) { atomicAdd(&(bar)[XB_TMO], 1u); break; } } } } while (0)

struct XcdBarrier {
    unsigned* bar; unsigned x;
    volatile LAS unsigned* st;
};

__device__ __forceinline__ XcdBarrier xcd_barrier_post(unsigned* bar, volatile LAS unsigned* st) {
    XcdBarrier b; b.bar = bar; b.x = xb_xcc_id(); b.st = st;
    if (threadIdx.x == 0) (void)xb_add(&bar[XB_XCNT(b.x)], 1u);
    return b;
}
__device__ __forceinline__ void xcd_barrier_complete(unsigned* bar, unsigned x, unsigned& nloc, unsigned& nx) {
    const unsigned G = gridDim.x * gridDim.y * gridDim.z;
    unsigned sum, cnt, mine, sp = 0u;
    for (;;) {
        sum = 0u; cnt = 0u; mine = 0u;
#pragma unroll
        for (unsigned j = 0; j < 16; ++j) { const unsigned c = xb_ld(&bar[XB_XCNT(j)]); sum += c; cnt += (c > 0u) ? 1u : 0u; mine = (j == x) ? c : mine; }
        if (sum == G) break;
        __builtin_amdgcn_s_sleep(1);
        if ((++sp & 255u) == 0u) { if (xb_ld(&bar[XB_TMO])) break; if (sp > XB_SPIN_CAP) { atomicAdd(&bar[XB_TMO], 1u); break; } }
    }
    nloc = mine > 0u ? mine : 1u; nx = cnt > 0u ? cnt : 1u;
}

__device__ __forceinline__ void xcd_barrier(const XcdBarrier& b) {
    asm volatile("s_waitcnt vmcnt(0)" ::: "memory");
    __syncthreads();
    if (threadIdx.x == 0) {
        unsigned* bar = b.bar;
        __builtin_amdgcn_s_waitcnt(0);
        unsigned nloc = b.st[0], nx = b.st[1];
        if (nloc == 0u) { xcd_barrier_complete(bar, b.x, nloc, nx); b.st[0] = nloc; b.st[1] = nx; }
        const unsigned old = xb_add(&bar[XB_XSUB(b.x)], 1u);
        const unsigned gen = old / nloc;
        if (old + 1u == (gen + 1u) * nloc) {
            __builtin_amdgcn_fence(__ATOMIC_RELEASE, "agent");
            asm volatile("s_waitcnt vmcnt(0)" ::: "memory");
            const unsigned og = xb_add(&bar[XB_TOP], 1u);
            const unsigned tg = og / nx;
            if (og + 1u == (tg + 1u) * nx) xb_add(&bar[XB_TOPGEN], 1u);
            else XB_SPIN(xb_ld(&bar[XB_TOPGEN]) == tg, bar);
            __builtin_amdgcn_fence(__ATOMIC_ACQUIRE, "agent");
            xb_add(&bar[XB_XGEN(b.x)], 1u);
            asm volatile("s_waitcnt vmcnt(0)" ::: "memory");
        } else {
            XB_SPIN(xb_ld(&bar[XB_XGEN(b.x)]) == gen, bar);
            __builtin_amdgcn_fence(__ATOMIC_ACQUIRE, "agent");
            asm volatile("s_waitcnt vmcnt(0)" ::: "memory");
        }
    }
    __syncthreads();
}

constexpr int L_BAR = LDS_BYTES - 128;
constexpr size_t CTL_BAR_OFF = 65536;
#ifndef PROBE_PHASE
#define PROBE_PHASE -1
#endif
constexpr int N_PHASES = 6;
__global__ void __launch_bounds__(NTHREADS, 2) fwd_megakernel(Params P) {
    extern __shared__ __attribute__((aligned(16))) unsigned char lds_raw[];
    Frame F;
    F.lds = (lbyte*)lds_raw;
    F.tid = threadIdx.x; F.lane = F.tid & 63; F.wave = __builtin_amdgcn_readfirstlane(F.tid >> 6);
    F.G = gridDim.x; { const int bx = blockIdx.x; F.vcu = (F.G % 8 == 0) ? (bx % 8) * (F.G / 8) + bx / 8 : bx; }
    F.ws = P.ws;
    { LAS unsigned* z = (LAS unsigned*)(F.lds + L_BAR); if (F.tid < 32) z[F.tid] = 0u; }
    __syncthreads();
    XcdBarrier bar = xcd_barrier_post((unsigned*)(P.ws + WS_CTL + CTL_BAR_OFF), (volatile LAS unsigned*)(F.lds + L_BAR));
    const int lo = P.ph_lo, hi = P.ph_hi;
#ifndef PH_MASK
#define PH_MASK 63
#endif
#define IN(k) (((PH_MASK >> (k)) & 1) && lo <= (k) && (k) < hi)
#define STAMP(k) do { if (PROBE_PHASE >= 0 && F.tid == 0) ((volatile LAS unsigned long long*)(F.lds + L_BAR + 16))[k] = __builtin_amdgcn_s_memrealtime(); } while (0)
#define SEAM(k) do { if (IN(k) && IN((k) + 1)) { xcd_barrier(bar); } STAMP((k) + 1); } while (0)
    STAMP(0);

    if (IN(0)) { p0_prologue(P, F); }
    if (PROBE_PHASE == 80 && F.tid == 0) ((volatile LAS unsigned long long*)(F.lds + L_BAR + 16))[7] = __builtin_amdgcn_s_memrealtime();
    SEAM(0);
    if (IN(1)) {
        pg8::Gemm g{F.HN(), F.WinT(), MPAD, ZLD, DM, F.HM(), F.WmemT()}; pg8::DualOrder S; S.init(MPAD, ZLD, 1024, 1024, F.G, (int)blockIdx.x);
        pg8::EpiDual E{pg8::EpiIn{F.Z(), F.QNR(), P.out, F.ROPE(), P.a_cmp, F.POOLP(), F.KV4()}, pg8::EpiMem{P.out, F.MKV()}};
        pg8::gemm_phase<pg8::EpiDual, pg8::DualOrder, true, true>(F.lds, g, S, E);
        { const int nun = S.n0 + S.n1, rem = nun % F.G, c = (int)blockIdx.x, NI = SBATCH * 256;
          if (rem == 0) pool_sample(P, F, c, F.G, NI);
          else { const int nidle = F.G - rem, n1 = nidle * 10 < NI ? nidle * 10 : NI;
                 if (c >= rem) pool_sample(P, F, c - rem, nidle, n1);
                 pool_sample(P, F, n1 + c, F.G, NI); } }
    }
    SEAM(1);
    if (IN(2)) { p2_cmp_finalize(P, F); }
    SEAM(2);
    if (IN(3)) { att::p3_attention(P, F, bar.x); }
    SEAM(3);
    const bool fuse_norm = (F.G == 256);
    if (IN(4)) {
        if (fuse_norm) p5_final_norm(P, F, MP);
        pg8::Gemm g{F.MIX(), F.WoutT(), MP, DM, DM, nullptr, nullptr}; pg8::StaticOrder S; S.init(MP, DM, F.G, (int)blockIdx.x);
        if (fuse_norm) { pg8::EpiOutNorm E{P.x_prompt, P.out, P.final_g, F.XB(), (unsigned*)(P.ws + WS_CTL + 131072)};
            pg8::gemm_phase<pg8::EpiOutNorm, pg8::StaticOrder, false, true>(F.lds, g, S, E); }
        else { pg8::EpiOut E{P.x_prompt, P.out, F.SSP()};
            pg8::gemm_phase<pg8::EpiOut, pg8::StaticOrder, false, true>(F.lds, g, S, E); }
    }
    if (!fuse_norm) { SEAM(4); if (IN(5)) p5_final_norm(P, F, 0); }
    if ((PROBE_PHASE >= 0 && PROBE_PHASE <= 10) || PROBE_PHASE == 13 || PROBE_PHASE >= 20) {
        __syncthreads(); STAMP(6); __syncthreads();
        volatile LAS unsigned long long* ts = (volatile LAS unsigned long long*)(F.lds + L_BAR + 16);
        const unsigned long long dt = PROBE_PHASE == 80 ? ts[1] - ts[7] : (PROBE_PHASE == 10 || PROBE_PHASE == 13 || PROBE_PHASE >= 20) ? ts[7] : ts[PROBE_PHASE + 1] - ts[PROBE_PHASE], t0 = __builtin_amdgcn_s_memrealtime();
        while (__builtin_amdgcn_s_memrealtime() - t0 < dt) __builtin_amdgcn_s_sleep(8);
    }
#undef IN
#undef SEAM
}

#ifndef MK_N_LAUNCHES
#define MK_N_LAUNCHES 1
#endif
extern "C" void kernel_launch(void* const* d_in, const int* in_sizes, int n_in, void* d_out, int out_size, void* d_ws, size_t ws_size, hipStream_t stream) {
    static int grid = 0;
    if (grid == 0) {
        if (n_in != 17 || (size_t)out_size != OFF_END || ws_size < WS_END) { fprintf(stderr, "kernel_launch: unexpected shapes (n_in %d out %d ws %zu)\n", n_in, out_size, ws_size); grid = -1; return; }
        int dev = 0, cus = 0, per_cu = 0;
        if (hipGetDevice(&dev) != hipSuccess || hipDeviceGetAttribute(&cus, hipDeviceAttributeMultiprocessorCount, dev) != hipSuccess) { grid = -1; return; }
        if (hipFuncSetAttribute((const void*)fwd_megakernel, hipFuncAttributeMaxDynamicSharedMemorySize, LDS_BYTES) != hipSuccess) { fprintf(stderr, "kernel_launch: hipFuncSetAttribute failed\n"); grid = -1; return; }
        if (hipOccupancyMaxActiveBlocksPerMultiprocessor(&per_cu, (const void*)fwd_megakernel, NTHREADS, LDS_BYTES) != hipSuccess || per_cu < 1) { fprintf(stderr, "kernel_launch: occupancy query says %d\n", per_cu); (void)hipGetLastError(); grid = -1; return; }
        grid = cus;
    }
    if (grid < 0) return;
    (void)hipMemsetAsync((char*)d_ws + WS_CTL, 0, CTL_BYTES, stream);
    Params p{};
    p.x_prompt = (const float*)d_in[0]; p.x_sample = (const float*)d_in[1]; p.cache_kv = (const float*)d_in[2]; p.cache_win = (const float*)d_in[3];
    p.state_conv = (const float*)d_in[4]; p.cache_mem = (const float*)d_in[5]; p.page_table = (const int*)d_in[6]; p.mem_prompt = (const float*)d_in[7];
    p.norm_g = (const float*)d_in[8]; p.w_in = (const float*)d_in[9]; p.w_conv = (const float*)d_in[10]; p.a_cmp = (const float*)d_in[11]; p.w_cmp = (const float*)d_in[12];
    p.mem_norm_g = (const float*)d_in[13]; p.w_mem_kv = (const float*)d_in[14]; p.w_out = (const float*)d_in[15]; p.final_g = (const float*)d_in[16];
    p.out = (float*)d_out; p.ws = (unsigned char*)d_ws;
#if MK_N_LAUNCHES == 1
    p.ph_lo = 0; p.ph_hi = N_PHASES;
    void* args[] = {&p};
    hipError_t e = hipLaunchCooperativeKernel((const void*)fwd_megakernel, dim3(grid), dim3(NTHREADS), args, LDS_BYTES, stream);
    if (e != hipSuccess) fprintf(stderr, "kernel_launch: cooperative launch failed: %s (grid %d)\n", hipGetErrorString(e), grid);
#else
    for (int k = 0; k < N_PHASES; ++k) { p.ph_lo = k; p.ph_hi = k + 1; hipLaunchKernelGGL(fwd_megakernel, dim3(grid), dim3(NTHREADS), LDS_BYTES, stream, p); }
#endif
}
```

```cpp
#include <hip/hip_runtime.h>
#include <hip/hip_cooperative_groups.h>
#include <cstdio>
#include <cstdint>
namespace cg = cooperative_groups;

constexpr int DM = 2048, PB = 4, PT = 2048, MP = PB * PT, SBATCH = 8, STOK = 4, MS = SBATCH * STOK, MALL = MP + MS, MPAD = 8448;
constexpr int INW = 6680, ZLD = 6912;
constexpr int ZC_CH = 0, ZC_CB = 512, ZC_CC = 1024, ZC_CG = 1536, ZC_Q = 2048, ZC_NG = 3072, ZC_KV = 4096, ZC_MQ = 5632, ZC_MG = 6144, ZC_BG = 6656;
constexpr int PAST = 16384, NPAGES = 128;
constexpr float NORM_EPS = 1e-6f;
constexpr size_t OFF_YP = 0, OFF_YS = OFF_YP + (size_t)MP * DM, OFF_KVP = OFF_YS + (size_t)MS * DM, OFF_WINP = OFF_KVP + (size_t)MP * 1024,
                 OFF_CONVP = OFF_WINP + (size_t)PB * 512 * 512, OFF_MEMP = OFF_CONVP + (size_t)PB * 2 * 512, OFF_KVS = OFF_MEMP + (size_t)PB * 256 * 1024,
                 OFF_WINS = OFF_KVS + (size_t)MS * 1024, OFF_CONVS = OFF_WINS + (size_t)SBATCH * 512 * 512, OFF_END = OFF_CONVS + (size_t)SBATCH * 2 * 512;
constexpr size_t MiB = 1u << 20;
constexpr size_t WS_CTL = 0, CTL_BYTES = 1 * MiB;
constexpr size_t WS_WIN = 1 * MiB, WS_WOUT = 28 * MiB, WS_WMEM = 36 * MiB, WS_HN = 40 * MiB, WS_HM = 73 * MiB, WS_Z = 77 * MiB, WS_MIX = 189 * MiB,
                 WS_MKV = 222 * MiB, WS_QNR = 224 * MiB, WS_POOLP = 229 * MiB, WS_POOLS = 230 * MiB, WS_KCP = 234 * MiB, WS_VCP = WS_KCP + 131072,
                 WS_KCS = 235 * MiB, WS_VCS = 236 * MiB, WS_ROPE = 237 * MiB, WS_TOT = 273 * MiB, WS_KV4 = 254 * MiB, WS_SSP = 271 * MiB, WS_SWIN = 322 * MiB, WS_SMB = 327 * MiB, WS_SELS = 332 * MiB, WS_XB = 368 * MiB, WS_END = 369 * MiB;
static_assert(WS_WIN + (size_t)ZLD * DM * 2 <= WS_WOUT && WS_HN + (size_t)MPAD * DM * 2 <= WS_HM && WS_Z + (size_t)MPAD * ZLD * 2 <= WS_MIX && WS_MIX + (size_t)MPAD * DM * 2 <= WS_MKV &&
              WS_QNR + (size_t)MPAD * 256 * 2 <= WS_POOLP && WS_POOLS + (size_t)SBATCH * 256 * 512 * 4 <= WS_KCP && WS_ROPE + 2052 * 32 * 4 <= WS_KV4 && WS_TOT + (size_t)256 * 4 * 3 * 4096 * 4 <= WS_END && WS_SSP + ((size_t)MP * 32 + MS * 256) * 4 <= WS_TOT && WS_KV4 + (size_t)4 * 8 * 2048 * 128 * 2 <= WS_SSP, "ws map");

#ifndef PROBE_PHASE
#define PROBE_PHASE -1
#endif
constexpr int NWAVES = 8, NTHREADS = 512;
constexpr int LDS_BYTES = 159744;

#define LAS __attribute__((address_space(3)))
typedef LAS unsigned char lbyte;
namespace pg8 {
#define PG8_LAS __attribute__((address_space(3)))
typedef unsigned short bf16_t;
typedef short bf16x8 __attribute__((ext_vector_type(8)));
typedef float f32x4 __attribute__((ext_vector_type(4)));
typedef unsigned u32x4 __attribute__((ext_vector_type(4)));
constexpr int BM = 256, BK = 64, HALF = 128, HTB = HALF * BK * 2  , STAGE_BYTES = 8 * HTB, NXCD = 8, WGM = 4;

__host__ __device__ __forceinline__ int lds_byte(int r, int c) { const int st = (r >> 4) * 2 + (c >> 5), rr = r & 15, cc = c & 31, ob = rr * 64 + cc * 2; return st * 1024 + (ob ^ (((ob >> 9) & 1) << 5)); }
__host__ __device__ __forceinline__ void stage_rc(int b, int& R, int& C) { const int st = b / 1024, sb = b % 1024, swz = sb ^ (((sb >> 9) & 1) << 5); R = (st >> 1) * 16 + swz / 64; C = (st & 1) * 32 + (swz % 64) / 2; }
__host__ __device__ __forceinline__ int perm32(int rho) { const int n = rho >> 4, i = rho & 15; return 8 * (i >> 2) + 4 * n + (i & 3); }

struct Unit { int pm, pn, which; };
struct Gemm { const bf16_t* A; const bf16_t* Bt; int M, N, K; const bf16_t* A2; const bf16_t* Bt2; };

struct StaticOrder {
    int nM, nN, nwg, G, c;
    __host__ __device__ void init(int M, int N, int G_, int c_) { nM = M / BM; nN = N / BM; nwg = nM * nN; G = G_; c = c_; }
    __host__ __device__ bool next(int i, Unit& u) const {
        const long L = (long)i * G + c; if (L >= nwg) return false;
        int wgid = (int)L; { const int q = nwg / NXCD, r = nwg % NXCD, xcd = wgid % NXCD, off = wgid / NXCD; wgid = (xcd < r ? xcd * (q + 1) : r * (q + 1) + (xcd - r) * q) + off; }
        const int nig = WGM * nN, gid = wgid / nig, fm = gid * WGM, gsz = (nM - fm) < WGM ? (nM - fm) : WGM;
        u.pm = fm + ((wgid % nig) % gsz); u.pn = (wgid % nig) / gsz; u.which = 0; return true;
    }
    __device__ __forceinline__ void a_ready(const Unit&) const {}
    __device__ __forceinline__ void done(const Unit&) const {}
};

__device__ __forceinline__ unsigned cvt_pk_bf16(float lo, float hi) { unsigned r; asm volatile("v_cvt_pk_bf16_f32 %0, %1, %2" : "=v"(r) : "v"(lo), "v"(hi)); return r; }
typedef float f32x2 __attribute__((ext_vector_type(2)));
template <class Epi, class Sched, bool ALIGN_EPI = false, bool SP2 = false>
__device__ __forceinline__ void gemm_phase(PG8_LAS unsigned char* lds, const Gemm g, const Sched& S, const Epi& E) {
    const int tid = threadIdx.x, wid = __builtin_amdgcn_readfirstlane(tid >> 6), lane = tid & 63, wr = wid >> 2, wc = wid & 3, fr = lane & 15, fq = lane >> 4;
    const int K = g.K, nt = K / BK;
    unsigned voffA[2], voffB[2];
#pragma unroll
    for (int i = 0; i < 2; ++i) { int R, C; stage_rc(tid * 16 + i * 8192, R, C); const int Rb = Epi::PERM ? ((R & ~31) + perm32(R & 31)) : R;
        voffA[i] = (unsigned)(R * K + C) * 2u; voffB[i] = (unsigned)(Rb * K + C) * 2u; }
    const size_t kstep = (size_t)(BK * 2);
    const size_t hstep = (size_t)HALF * K * 2;
    const size_t tstep = 2 * hstep;
    const unsigned ldsw = (unsigned)wid * 1024u;
    const int aoff = lds_byte(wr * 64 + fr, fq * 8), boff = lds_byte(wc * 32 + fr, fq * 8);
#define PG8_SA(b, h) (((b) * 2 + (h)) * HTB)
#define PG8_SB(b, h) ((4 + (b) * 2 + (h)) * HTB)
#define PG8_STAGE(bufoff, gbase, voff) do { _Pragma("unroll") for (int _i = 0; _i < 2; ++_i) \
        __builtin_amdgcn_global_load_lds((const unsigned*)((const char*)(gbase) + (voff)[_i]), (PG8_LAS unsigned*)(lds + (bufoff) + ldsw + _i * 8192), 16, 0, 0); } while (0)
#define PG8_LDA(dst, b, h) do { _Pragma("unroll") for (int m = 0; m < 4; ++m) _Pragma("unroll") for (int k = 0; k < 2; ++k) dst[m][k] = *(const PG8_LAS bf16x8*)(lds + PG8_SA(b, h) + aoff + m * 2048 + k * 1024); } while (0)
#define PG8_LDB(dst, b, h) do { _Pragma("unroll") for (int n = 0; n < 2; ++n) _Pragma("unroll") for (int k = 0; k < 2; ++k) dst[n][k] = *(const PG8_LAS bf16x8*)(lds + PG8_SB(b, h) + boff + n * 2048 + k * 1024); } while (0)
#define PG8_MMA(ai, bj, At, Bt) do { __builtin_amdgcn_s_setprio(1); _Pragma("unroll") for (int m = 0; m < 4; ++m) _Pragma("unroll") for (int n = 0; n < 2; ++n) _Pragma("unroll") for (int k = 0; k < 2; ++k) \
        acc[ai][bj][m][n] = __builtin_amdgcn_mfma_f32_16x16x32_bf16(Bt[n][k], At[m][k], acc[ai][bj][m][n], 0, 0, 0); __builtin_amdgcn_s_setprio(0); } while (0)
#define PG8_WAIT_V(n) asm volatile("s_waitcnt vmcnt(" #n ")" ::: "memory")
#define PG8_WAIT_L(n) asm volatile("s_waitcnt lgkmcnt(" #n ")" ::: "memory")
#define PG8_BAR __builtin_amdgcn_s_barrier()
#define PG8_SCHED __builtin_amdgcn_sched_barrier(0)
    Unit cur, nxt; int ui = 0;
    if (!S.next(0, cur)) return;
    f32x4 acc[2][2][4][2];
#pragma unroll
    for (int a = 0; a < 2; ++a)
#pragma unroll
        for (int b = 0; b < 2; ++b)
#pragma unroll
            for (int m = 0; m < 4; ++m)
#pragma unroll
                for (int n = 0; n < 2; ++n) acc[a][b][m][n] = (f32x4){0.f, 0.f, 0.f, 0.f};
    bf16x8 At[4][2], B0[2][2], B1[2][2];
    const char* cA = (const char*)(cur.which ? g.A2 : g.A) + (size_t)cur.pm * tstep; const char* cB = (const char*)(cur.which ? g.Bt2 : g.Bt) + (size_t)cur.pn * tstep;
    S.a_ready(cur);
    if constexpr (SP2) {
        PG8_STAGE(PG8_SB(0, 0), cB, voffB); PG8_STAGE(PG8_SB(0, 1), cB + hstep, voffB); PG8_STAGE(PG8_SA(0, 0), cA, voffA); PG8_STAGE(PG8_SA(0, 1), cA + hstep, voffA);
        if (wr == 1) PG8_BAR;
        PG8_WAIT_V(2); PG8_BAR;
        PG8_STAGE(PG8_SB(1, 0), cB + kstep, voffB); PG8_STAGE(PG8_SA(1, 0), cA + kstep, voffA); PG8_STAGE(PG8_SB(1, 1), cB + hstep + kstep, voffB);
        PG8_WAIT_V(6); PG8_BAR;
    } else {
        PG8_STAGE(PG8_SB(0, 0), cB, voffB); PG8_STAGE(PG8_SA(0, 0), cA, voffA); PG8_STAGE(PG8_SB(0, 1), cB + hstep, voffB); PG8_STAGE(PG8_SA(0, 1), cA + hstep, voffA);
        if (wr == 1) PG8_BAR;
        PG8_WAIT_V(4); PG8_BAR;
        PG8_STAGE(PG8_SB(1, 0), cB + kstep, voffB); PG8_STAGE(PG8_SA(1, 0), cA + kstep, voffA); PG8_STAGE(PG8_SB(1, 1), cB + hstep + kstep, voffB);
        PG8_WAIT_V(6); PG8_BAR;
    }
    for (;;) {
        const bool has_next = S.next(ui + 1, nxt);
        const char* nA = has_next ? (const char*)(nxt.which ? g.A2 : g.A) + (size_t)nxt.pm * tstep : cA; const char* nB = has_next ? (const char*)(nxt.which ? g.Bt2 : g.Bt) + (size_t)nxt.pn * tstep : cB;
        for (int t = 0; t < nt; t += 2) {
            const bool last = (t == nt - 2);
            const char* a1 = cA + (size_t)(t + 1) * kstep;
            const char* a2 = last ? nA : cA + (size_t)(t + 2) * kstep; const char* b2 = last ? nB : cB + (size_t)(t + 2) * kstep;
            const char* a3 = a2 + kstep; const char* b3 = b2 + kstep;
            if (last && has_next) S.a_ready(nxt);
            if constexpr (SP2) {
            PG8_LDB(B0, 0, 0); PG8_LDB(B1, 0, 1); PG8_SCHED; PG8_LDA(At, 0, 0); PG8_STAGE(PG8_SA(1, 1), a1 + hstep, voffA);
            PG8_WAIT_V(8); PG8_WAIT_L(0); PG8_BAR; PG8_MMA(0, 0, At, B0); PG8_MMA(0, 1, At, B1); PG8_BAR; PG8_SCHED;
            PG8_LDA(At, 0, 1); PG8_STAGE(PG8_SB(0, 0), b2, voffB); PG8_STAGE(PG8_SB(0, 1), b2 + hstep, voffB); PG8_STAGE(PG8_SA(0, 0), a2, voffA);
            PG8_WAIT_V(8); PG8_WAIT_L(0); PG8_BAR; PG8_MMA(1, 0, At, B0); PG8_MMA(1, 1, At, B1); PG8_BAR; PG8_SCHED;
            PG8_LDB(B0, 1, 0); PG8_LDB(B1, 1, 1); PG8_SCHED; PG8_LDA(At, 1, 0); PG8_STAGE(PG8_SA(0, 1), a2 + hstep, voffA);
            PG8_WAIT_V(8); PG8_WAIT_L(0); PG8_BAR; PG8_MMA(0, 0, At, B0); PG8_MMA(0, 1, At, B1); PG8_BAR; PG8_SCHED;
            PG8_LDA(At, 1, 1); PG8_STAGE(PG8_SB(1, 0), b3, voffB); PG8_STAGE(PG8_SB(1, 1), b3 + hstep, voffB); PG8_STAGE(PG8_SA(1, 0), a3, voffA);
            PG8_WAIT_V(8); PG8_WAIT_L(0); PG8_BAR; PG8_MMA(1, 0, At, B0); PG8_MMA(1, 1, At, B1); PG8_BAR; PG8_SCHED;
            } else {
            PG8_LDB(B0, 0, 0); PG8_SCHED; PG8_LDA(At, 0, 0); PG8_STAGE(PG8_SA(1, 1), a1 + hstep, voffA);
            PG8_WAIT_L(8); PG8_BAR; PG8_WAIT_L(0); PG8_MMA(0, 0, At, B0); PG8_BAR; PG8_SCHED;
            PG8_LDB(B1, 0, 1); PG8_STAGE(PG8_SB(0, 0), b2, voffB);
            PG8_BAR; PG8_WAIT_L(0); PG8_MMA(0, 1, At, B1); PG8_BAR;
            PG8_LDA(At, 0, 1); PG8_STAGE(PG8_SA(0, 0), a2, voffA);
            PG8_BAR; PG8_WAIT_L(0); PG8_MMA(1, 0, At, B0); PG8_BAR; PG8_SCHED;
            PG8_STAGE(PG8_SB(0, 1), b2 + hstep, voffB);
            PG8_WAIT_V(6); PG8_BAR; PG8_MMA(1, 1, At, B1); PG8_BAR;
            PG8_LDB(B0, 1, 0); PG8_SCHED; PG8_LDA(At, 1, 0); PG8_STAGE(PG8_SA(0, 1), a2 + hstep, voffA);
            PG8_WAIT_L(8); PG8_BAR; PG8_WAIT_L(0); PG8_MMA(0, 0, At, B0); PG8_BAR; PG8_SCHED;
            PG8_LDB(B1, 1, 1); PG8_STAGE(PG8_SB(1, 0), b3, voffB);
            PG8_BAR; PG8_WAIT_L(0); PG8_MMA(0, 1, At, B1); PG8_BAR;
            PG8_LDA(At, 1, 1); PG8_STAGE(PG8_SA(1, 0), a3, voffA);
            PG8_BAR; PG8_WAIT_L(0); PG8_MMA(1, 0, At, B0); PG8_BAR; PG8_SCHED;
            PG8_STAGE(PG8_SB(1, 1), b3 + hstep, voffB);
            PG8_WAIT_V(6); PG8_BAR; PG8_MMA(1, 1, At, B1); PG8_BAR;
            }
        }
        if constexpr (ALIGN_EPI) { if (wr == 0) PG8_BAR; }
        if constexpr (!Epi::AFTER_DRAIN) { E(acc, cur, wr, wc, fr, fq); S.done(cur); }
        if (!has_next) break;
#pragma unroll
        for (int a = 0; a < 2; ++a)
#pragma unroll
            for (int b = 0; b < 2; ++b)
#pragma unroll
                for (int m = 0; m < 4; ++m)
#pragma unroll
                    for (int n = 0; n < 2; ++n) acc[a][b][m][n] = (f32x4){0.f, 0.f, 0.f, 0.f};
        cur = nxt; cA = nA; cB = nB; ++ui;
        if constexpr (ALIGN_EPI) { if (wr == 1) PG8_BAR; }
    }
    PG8_WAIT_V(0);
    if constexpr (!ALIGN_EPI) { if (wr == 0) PG8_BAR; }
    PG8_BAR;
    if constexpr (Epi::AFTER_DRAIN) { E.fused(acc, cur, wr, wc, fr, fq, lds, wid, lane); S.done(cur); }
#undef PG8_SA
#undef PG8_SB
#undef PG8_STAGE
#undef PG8_LDA
#undef PG8_LDB
#undef PG8_MMA
#undef PG8_WAIT_V
#undef PG8_WAIT_L
#undef PG8_BAR
#undef PG8_SCHED
}
}

namespace pg8 {
typedef unsigned u32x2 __attribute__((ext_vector_type(2)));
struct EpiIn {
    static constexpr bool PERM = false, AFTER_DRAIN = false;
    bf16_t* Z; bf16_t* QNR; float* out; const float* rope; const float* acmp; float* poolp; bf16_t* KV4;
    static __device__ __forceinline__ void st_bf16x4(bf16_t* p, const f32x4 v) { u32x2 w; w.x = cvt_pk_bf16(v[0], v[1]); w.y = cvt_pk_bf16(v[2], v[3]); *(u32x2*)p = w; }
    static __device__ __forceinline__ void st_bf16_rows2(bf16_t* pp, const f32x4 va, const f32x4 vb) {
        unsigned a0 = cvt_pk_bf16(va[0], va[1]), a1 = cvt_pk_bf16(va[2], va[3]), b0 = cvt_pk_bf16(vb[0], vb[1]), b1 = cvt_pk_bf16(vb[2], vb[3]);
        auto s0 = __builtin_amdgcn_permlane16_swap(a0, b0, false, false); auto s1 = __builtin_amdgcn_permlane16_swap(a1, b1, false, false);
        u32x4 w; w.x = s0[0]; w.y = s1[0]; w.z = s0[1]; w.w = s1[1];
        *(u32x4*)pp = w;
    }
    __device__ __forceinline__ void operator()(const f32x4 (&acc)[2][2][4][2], const Unit& u, int wr, int wc, int fr, int fq) const {
        if (u.pm >= MP / BM) { generic(acc, u, wr, wc, fr, fq); return; }
        const int pn = u.pn, row0 = u.pm * BM + wr * 64 + fr, cc0 = wc * 32 + 4 * fq;
        if (pn == 16 || pn == 17) {
            float* o0 = out + OFF_KVP + (size_t)row0 * 1024 + (pn - 16) * 256 + cc0;
#pragma unroll
            for (int ai = 0; ai < 2; ++ai)
#pragma unroll
                for (int m = 0; m < 4; ++m) { float* op = o0 + (size_t)(ai * HALF + m * 16) * 1024;
#pragma unroll
                    for (int bj = 0; bj < 2; ++bj) { __builtin_nontemporal_store(acc[ai][bj][m][0], (f32x4*)(op + bj * HALF)); __builtin_nontemporal_store(acc[ai][bj][m][1], (f32x4*)(op + bj * HALF + 16)); } }
            pool_partials(acc, u, wr, wc, fr, fq, pn - 16);
            return;
        }
        const bool rot = (wc == 0) && ((pn >= 8 && pn < 12) || pn == 18 || pn == 20);
        if (pn >= 18 && pn < 22) {
            const int p = pn - 16; const bool winout = p >= 4 && (u.pm & 7) >= 6;
#pragma unroll
            for (int ai = 0; ai < 2; ++ai)
#pragma unroll
                for (int m = 0; m < 4; ++m) { const int row = row0 + ai * HALF + m * 16, t = row & (PT - 1), b = row >> 11;
                    f32x4 cs4, sn4; if (rot) { cs4 = *(const f32x4*)(rope + t * 32 + 4 * fq); sn4 = *(const f32x4*)(rope + t * 32 + 16 + 4 * fq); }
#pragma unroll
                    for (int bj = 0; bj < 2; ++bj) { f32x4 v0 = acc[ai][bj][m][0], v1 = acc[ai][bj][m][1];
                        if (rot) { const f32x4 r0 = v0 * cs4 - v1 * sn4, r1 = v1 * cs4 + v0 * sn4; v0 = r0; v1 = r1; }
                        bf16_t* kp = KV4 + ((size_t)((pn - 18) * 8 + b * 2 + bj) * PT + t) * 128 + cc0; st_bf16x4(kp, v0); st_bf16x4(kp + 16, v1);
                        float* op = p < 4 ? out + OFF_KVP + (size_t)row * 1024 + p * 256 + bj * HALF + cc0 : out + OFF_WINP + ((size_t)(b * 512 + t - (PT - 512)) * 2 + (p - 4)) * 256 + bj * HALF + cc0;
                        if (p < 4 || winout) { __builtin_nontemporal_store(v0, (f32x4*)op); __builtin_nontemporal_store(v1, (f32x4*)(op + 16)); } } }
            return;
        }
        if (rot) {
#pragma unroll
            for (int ai = 0; ai < 2; ++ai)
#pragma unroll
                for (int m = 0; m < 4; ++m) { const int row = row0 + ai * HALF + m * 16, t = row & (PT - 1);
                    const f32x4 cs4 = *(const f32x4*)(rope + t * 32 + 4 * fq), sn4 = *(const f32x4*)(rope + t * 32 + 16 + 4 * fq);
                    bf16_t* zp = Z + (size_t)row * ZLD + pn * BM + cc0;
#pragma unroll
                    for (int bj = 0; bj < 2; ++bj) { const f32x4 v0 = acc[ai][bj][m][0], v1 = acc[ai][bj][m][1];
                        bf16_t* qp = QNR + ((size_t)row * 8 + (pn - 8) * 2 + bj) * 32 + 4 * fq; st_bf16x4(qp, v0); st_bf16x4(qp + 16, v1);
                        st_bf16x4(zp + bj * HALF, v0 * cs4 - v1 * sn4); st_bf16x4(zp + bj * HALF + 16, v1 * cs4 + v0 * sn4); } }
        } else {
#pragma unroll
            for (int ai = 0; ai < 2; ++ai)
#pragma unroll
                for (int mp = 0; mp < 4; mp += 2) { bf16_t* zp = Z + (size_t)(row0 + ai * HALF + mp * 16 + (fq & 1) * 16) * ZLD + pn * BM + cc0 - (fq & 1) * 4;
#pragma unroll
                    for (int bj = 0; bj < 2; ++bj) { st_bf16_rows2(zp + bj * HALF, acc[ai][bj][mp][0], acc[ai][bj][mp + 1][0]);
                                                     st_bf16_rows2(zp + bj * HALF + 16, acc[ai][bj][mp][1], acc[ai][bj][mp + 1][1]); } }
        }
    }
    __device__ __forceinline__ void pool_partials(const f32x4 (&acc)[2][2][4][2], const Unit& u, int wr, int wc, int fr, int fq, int part) const {
#pragma unroll
        for (int ai = 0; ai < 2; ++ai)
#pragma unroll
            for (int bj = 0; bj < 2; ++bj)
#pragma unroll
                for (int n = 0; n < 2; ++n) {
                    const int d = wc * 32 + n * 16 + 4 * fq;
                    f32x4 s = (f32x4){0.f, 0.f, 0.f, 0.f};
#pragma unroll
                    for (int m = 0; m < 4; ++m) { const f32x4 a = *(const f32x4*)(acmp + ((size_t)part * 64 + m * 16 + fr) * 128 + d); s += a * acc[ai][bj][m][n]; }
#pragma unroll
                    for (int i = 0; i < 4; ++i) { float x = s[i]; x += __shfl_xor(x, 1); x += __shfl_xor(x, 2); x += __shfl_xor(x, 4); x += __shfl_xor(x, 8); s[i] = x; }
                    if (fr == 0) { const int b = u.pm >> 3, nb = (u.pm & 7) * 4 + ai * 2 + wr;
                        *(f32x4*)(poolp + ((((size_t)b * 32 + nb) * 2 + part) * 2 + bj) * 128 + d) = s; }
                }
    }
    __device__ __forceinline__ void generic(const f32x4 (&acc)[2][2][4][2], const Unit& u, int wr, int wc, int fr, int fq) const {
        const int pn = u.pn;
        const bool is_q = (pn >= 8 && pn < 12), is_kv = (pn >= 16 && pn < 22);
        const bool do_rope = (wc == 0) && (is_q || pn == 18 || pn == 20);
        const bool do_z = !(pn == 16 || pn == 17);
#pragma unroll
        for (int ai = 0; ai < 2; ++ai)
#pragma unroll
            for (int m = 0; m < 4; ++m) {
                const int row = u.pm * BM + ai * HALF + wr * 64 + m * 16 + fr;
                if (row >= MALL) continue;
                const int posidx = row < MP ? (row & (PT - 1)) : (PT + ((row - MP) & 3));
                f32x4 cs4 = (f32x4){1.f, 1.f, 1.f, 1.f}, sn4 = (f32x4){0.f, 0.f, 0.f, 0.f};
                if (do_rope) { cs4 = *(const f32x4*)(rope + posidx * 32 + 4 * fq); sn4 = *(const f32x4*)(rope + posidx * 32 + 16 + 4 * fq); }
#pragma unroll
                for (int bj = 0; bj < 2; ++bj) {
                    f32x4 v0 = acc[ai][bj][m][0], v1 = acc[ai][bj][m][1];
                    if (do_rope) {
                        if (is_q) {
                            const int head = (pn - 8) * 2 + bj;
                            bf16_t* qp = QNR + ((size_t)row * 8 + head) * 32 + 4 * fq;
                            u32x2 w0; w0.x = cvt_pk_bf16(v0[0], v0[1]); w0.y = cvt_pk_bf16(v0[2], v0[3]); *(u32x2*)qp = w0;
                            u32x2 w1; w1.x = cvt_pk_bf16(v1[0], v1[1]); w1.y = cvt_pk_bf16(v1[2], v1[3]); *(u32x2*)(qp + 16) = w1;
                        }
                        const f32x4 r0 = v0 * cs4 - v1 * sn4, r1 = v1 * cs4 + v0 * sn4; v0 = r0; v1 = r1;
                    }
                    const int cc = bj * HALF + wc * 32 + 4 * fq;
                    if (pn >= 18 && pn < 22 && row < MP) {
                        bf16_t* kp = KV4 + ((size_t)((pn - 18) * 8 + (row >> 11) * 2 + bj) * PT + (row & (PT - 1))) * 128 + wc * 32 + 4 * fq;
                        u32x2 w0; w0.x = cvt_pk_bf16(v0[0], v0[1]); w0.y = cvt_pk_bf16(v0[2], v0[3]); *(u32x2*)kp = w0;
                        u32x2 w1; w1.x = cvt_pk_bf16(v1[0], v1[1]); w1.y = cvt_pk_bf16(v1[2], v1[3]); *(u32x2*)(kp + 16) = w1;
                    } else if (do_z) {
                        bf16_t* zp = Z + (size_t)row * ZLD + pn * BM + cc;
                        u32x2 w0; w0.x = cvt_pk_bf16(v0[0], v0[1]); w0.y = cvt_pk_bf16(v0[2], v0[3]); *(u32x2*)zp = w0;
                        u32x2 w1; w1.x = cvt_pk_bf16(v1[0], v1[1]); w1.y = cvt_pk_bf16(v1[2], v1[3]); *(u32x2*)(zp + 16) = w1;
                    }
                    if (is_kv) {
                        const int p = pn - 16; float* op = nullptr;
                        if (row < MP) {
                            if (p < 4) op = out + OFF_KVP + (size_t)row * 1024 + p * 256 + cc;
                            else { const int t = row & (PT - 1); if (t >= PT - 512) op = out + OFF_WINP + ((size_t)((row >> 11) * 512 + t - (PT - 512)) * 2 + (p - 4)) * 256 + cc; }
                        } else {
                            const int rs = row - MP;
                            if (p < 4) op = out + OFF_KVS + (size_t)rs * 1024 + p * 256 + cc;
                            else op = out + OFF_WINS + ((size_t)((rs >> 2) * 512 + 508 + (rs & 3)) * 2 + (p - 4)) * 256 + cc;
                        }
                        if (op) { *(f32x4*)op = v0; *(f32x4*)(op + 16) = v1; }
                    }
                }
            }
        if ((pn == 16 || pn == 17) && u.pm < MP / BM) {
            const int part = pn - 16;
#pragma unroll
            for (int ai = 0; ai < 2; ++ai)
#pragma unroll
                for (int bj = 0; bj < 2; ++bj)
#pragma unroll
                    for (int n = 0; n < 2; ++n) {
                        const int d = wc * 32 + n * 16 + 4 * fq;
                        f32x4 s = (f32x4){0.f, 0.f, 0.f, 0.f};
#pragma unroll
                        for (int m = 0; m < 4; ++m) { const f32x4 a = *(const f32x4*)(acmp + ((size_t)part * 64 + m * 16 + fr) * 128 + d); s += a * acc[ai][bj][m][n]; }
#pragma unroll
                        for (int i = 0; i < 4; ++i) { float x = s[i]; x += __shfl_xor(x, 1); x += __shfl_xor(x, 2); x += __shfl_xor(x, 4); x += __shfl_xor(x, 8); s[i] = x; }
                        if (fr == 0) { const int b = u.pm >> 3, nb = (u.pm & 7) * 4 + ai * 2 + wr;
                            *(f32x4*)(poolp + ((((size_t)b * 32 + nb) * 2 + part) * 2 + bj) * 128 + d) = s; }
                    }
        }
    }
};
struct EpiMem {
    static constexpr bool PERM = false, AFTER_DRAIN = false;
    float* out; bf16_t* MKV;
    __device__ __forceinline__ void operator()(const f32x4 (&acc)[2][2][4][2], const Unit& u, int wr, int wc, int fr, int fq) const {
#pragma unroll
        for (int ai = 0; ai < 2; ++ai)
#pragma unroll
            for (int m = 0; m < 4; ++m) {
                const int row = u.pm * BM + ai * HALF + wr * 64 + m * 16 + fr;
#pragma unroll
                for (int bj = 0; bj < 2; ++bj)
#pragma unroll
                    for (int n = 0; n < 2; ++n) {
                        const int c = u.pn * BM + bj * HALF + wc * 32 + n * 16 + 4 * fq; const f32x4 v = acc[ai][bj][m][n];
                        *(f32x4*)(out + OFF_MEMP + (size_t)row * 1024 + c) = v;
                        u32x2 w; w.x = cvt_pk_bf16(v[0], v[1]); w.y = cvt_pk_bf16(v[2], v[3]); *(u32x2*)(MKV + (size_t)row * 1024 + c) = w;
                    }
            }
    }
};
struct EpiOut {
    static constexpr bool PERM = false, AFTER_DRAIN = false;
    const float* xp; float* out; float* ssp;
    __device__ __forceinline__ void operator()(const f32x4 (&acc)[2][2][4][2], const Unit& u, int wr, int wc, int fr, int fq) const {
#pragma unroll
        for (int ai = 0; ai < 2; ++ai)
#pragma unroll
            for (int m = 0; m < 4; ++m) {
                const int row = u.pm * BM + ai * HALF + wr * 64 + m * 16 + fr;
                const float* xr = xp + (size_t)row * DM; float* orow = out + OFF_YP + (size_t)row * DM;
                float q = 0.f;
#pragma unroll
                for (int bj = 0; bj < 2; ++bj)
#pragma unroll
                    for (int n = 0; n < 2; ++n) {
                        const int c = u.pn * BM + bj * HALF + wc * 32 + n * 16 + 4 * fq;
                        const f32x4 v = acc[ai][bj][m][n] + *(const f32x4*)(xr + c);
                        *(f32x4*)(orow + c) = v; q += (v[0] * v[0] + v[1] * v[1]) + (v[2] * v[2] + v[3] * v[3]);
                    }
                q += __shfl_xor(q, 16); q += __shfl_xor(q, 32);
                if (fq == 0) ssp[(size_t)row * 32 + u.pn * 4 + wc] = q;
            }
    }
};
struct EpiOutNorm {
    static constexpr bool PERM = false, AFTER_DRAIN = true;
    const float* xp; float* out; const float* fg; float* xbuf; unsigned* cnt;
    __device__ __forceinline__ void operator()(const f32x4 (&)[2][2][4][2], const Unit&, int, int, int, int) const {}
    __device__ __forceinline__ void fused(f32x4 (&acc)[2][2][4][2], const Unit& u, int wr, int wc, int fr, int fq, PG8_LAS unsigned char* lds, int wid, int lane) const {
        PG8_LAS float* Pl = (PG8_LAS float*)lds;
        PG8_LAS float* Sl = (PG8_LAS float*)(lds + 4096);
        PG8_LAS unsigned* flag = (PG8_LAS unsigned*)(lds + 4096 + 1024);
        const int col0 = u.pn * BM + wc * 32 + 4 * fq;
#pragma unroll
        for (int ai = 0; ai < 2; ++ai)
#pragma unroll
            for (int m = 0; m < 4; ++m) { const int rl = ai * HALF + wr * 64 + m * 16 + fr; const float* xr = xp + (size_t)(u.pm * BM + rl) * DM + col0; float q = 0.f;
#pragma unroll
                for (int bj = 0; bj < 2; ++bj)
#pragma unroll
                    for (int n = 0; n < 2; ++n) { const f32x4 v = acc[ai][bj][m][n] + __builtin_nontemporal_load((const f32x4*)(xr + bj * HALF + n * 16)); acc[ai][bj][m][n] = v; q += (v[0] * v[0] + v[1] * v[1]) + (v[2] * v[2] + v[3] * v[3]); }
                q += __shfl_xor(q, 16); q += __shfl_xor(q, 32);
                if (fq == 0) Pl[rl * 4 + wc] = q;
                if (m & 1) asm volatile("" ::: "memory"); }
        asm volatile("s_waitcnt lgkmcnt(0)" ::: "memory"); __builtin_amdgcn_s_barrier(); asm volatile("" ::: "memory");
        f32x4 gv[2][2];
#pragma unroll
        for (int bj = 0; bj < 2; ++bj)
#pragma unroll
            for (int n = 0; n < 2; ++n) gv[bj][n] = *(const f32x4*)(fg + col0 + bj * HALF + n * 16);
        const int row = wid * 64 + lane;
        if (wid < 4) { const float s = (Pl[row * 4] + Pl[row * 4 + 1]) + (Pl[row * 4 + 2] + Pl[row * 4 + 3]);
            __hip_atomic_store(xbuf + (size_t)(u.pm * BM + row) * 8 + u.pn, s, __ATOMIC_RELAXED, __HIP_MEMORY_SCOPE_AGENT);
            asm volatile("s_waitcnt vmcnt(0)" ::: "memory");
            if (lane == 0) __hip_atomic_fetch_add(cnt + 64 * u.pm, 1u, __ATOMIC_RELAXED, __HIP_MEMORY_SCOPE_AGENT); }
        if (wid == 0) { unsigned sp = 0;
            while ((unsigned)__builtin_amdgcn_readfirstlane(__hip_atomic_load(cnt + 64 * u.pm, __ATOMIC_RELAXED, __HIP_MEMORY_SCOPE_AGENT)) < 32u) { __builtin_amdgcn_s_sleep(2); if (++sp > (1u << 22)) break; }
            if (lane == 0) flag[0] = 1u; }
        asm volatile("s_waitcnt vmcnt(0) lgkmcnt(0)" ::: "memory"); __builtin_amdgcn_s_barrier(); asm volatile("" ::: "memory");
        if (wid < 4) { float t = 0.f;
#pragma unroll
            for (int k = 0; k < 8; ++k) t += __hip_atomic_load(xbuf + (size_t)(u.pm * BM + row) * 8 + k, __ATOMIC_RELAXED, __HIP_MEMORY_SCOPE_AGENT);
            Sl[row] = 1.0f / sqrtf(t * (1.f / DM) + NORM_EPS); }
        asm volatile("s_waitcnt lgkmcnt(0)" ::: "memory"); __builtin_amdgcn_s_barrier(); asm volatile("" ::: "memory");
#pragma unroll
        for (int ai = 0; ai < 2; ++ai)
#pragma unroll
            for (int m = 0; m < 4; ++m) { const int rl = ai * HALF + wr * 64 + m * 16 + fr; const float rs = Sl[rl]; float* orow = out + OFF_YP + (size_t)(u.pm * BM + rl) * DM + col0;
#pragma unroll
                for (int bj = 0; bj < 2; ++bj)
#pragma unroll
                    for (int n = 0; n < 2; ++n) __builtin_nontemporal_store(acc[ai][bj][m][n] * rs * gv[bj][n], (f32x4*)(orow + bj * HALF + n * 16)); }
    }
};
struct DualOrder {
    StaticOrder s0; int n0, n1, nN1;
    __host__ __device__ void init(int M0, int N0, int M1, int N1, int G_, int c_) { s0.init(M0, N0, G_, c_); n0 = s0.nwg; nN1 = N1 / BM; n1 = (M1 / BM) * nN1; }
    __host__ __device__ bool next(int i, Unit& u) const {
        const long L = (long)i * s0.G + s0.c; if (L >= n0 + n1) return false;
        if (L < n0) return s0.next(i, u);
        const int r = (int)(L - n0); u.pm = r / nN1; u.pn = r % nN1; u.which = 1; return true;
    }
    __device__ __forceinline__ void a_ready(const Unit&) const {}
    __device__ __forceinline__ void done(const Unit&) const {}
};
struct EpiDual {
    static constexpr bool PERM = false, AFTER_DRAIN = false;
    EpiIn e0; EpiMem e1;
    __device__ __forceinline__ void operator()(const f32x4 (&acc)[2][2][4][2], const Unit& u, int wr, int wc, int fr, int fq) const { if (u.which) e1(acc, u, wr, wc, fr, fq); else { e0(acc, u, wr, wc, fr, fq); if (PROBE_PHASE == 70) { asm volatile("" ::: "memory"); e0(acc, u, wr, wc, fr, fq); } } }
};
}

typedef unsigned short bf16;
typedef unsigned v4u __attribute__((ext_vector_type(4)));
typedef unsigned v2u __attribute__((ext_vector_type(2)));
typedef float f32x4 __attribute__((ext_vector_type(4)));
typedef float f32x2 __attribute__((ext_vector_type(2)));
typedef float f32x16 __attribute__((ext_vector_type(16)));
typedef short bf16x8 __attribute__((ext_vector_type(8)));
typedef short s16x4 __attribute__((ext_vector_type(4)));
#define LDS_WAIT() asm volatile("s_waitcnt lgkmcnt(0)" ::: "memory")
__device__ __forceinline__ unsigned cvtpk(float lo, float hi) { unsigned r; asm volatile("v_cvt_pk_bf16_f32 %0, %1, %2" : "=v"(r) : "v"(lo), "v"(hi)); return r; }
__device__ __forceinline__ float bf2f(bf16 v) { return __uint_as_float(((unsigned)v) << 16); }
__device__ __forceinline__ float wave_sum(float v) {
#pragma unroll
    for (int o = 1; o < 64; o <<= 1) v += __shfl_xor(v, o);
    return v;
}

struct Params {
    const float* x_prompt; const float* x_sample; const float* cache_kv; const float* cache_win; const float* state_conv; const float* cache_mem;
    const int* page_table; const float* mem_prompt; const float* norm_g; const float* w_in; const float* w_conv; const float* a_cmp; const float* w_cmp;
    const float* mem_norm_g; const float* w_mem_kv; const float* w_out; const float* final_g;
    float* out; unsigned char* ws; int ph_lo, ph_hi;
};
struct Frame {
    lbyte* lds; int tid, lane, wave, vcu, G; unsigned char* ws;
#define WSP(T, name, off) __device__ __forceinline__ T* name() const { return (T*)(ws + (off)); }
    WSP(bf16, WinT, WS_WIN) WSP(bf16, WoutT, WS_WOUT) WSP(bf16, WmemT, WS_WMEM) WSP(bf16, HN, WS_HN) WSP(bf16, HM, WS_HM) WSP(bf16, Z, WS_Z) WSP(bf16, MIX, WS_MIX) WSP(bf16, MKV, WS_MKV)
    WSP(bf16, QNR, WS_QNR) WSP(bf16, KCP, WS_KCP) WSP(bf16, VCP, WS_VCP) WSP(bf16, KCS, WS_KCS) WSP(bf16, VCS, WS_VCS)
    WSP(float, POOLP, WS_POOLP) WSP(float, POOLS, WS_POOLS) WSP(float, ROPE, WS_ROPE) WSP(float, SS, WS_CTL + 4096) WSP(unsigned, QUEUE, WS_CTL) WSP(float, TOT, WS_TOT) WSP(bf16, KV4, WS_KV4) WSP(float, SSP, WS_SSP) WSP(bf16, SWIN, WS_SWIN) WSP(bf16, SMB, WS_SMB) WSP(bf16, SELS, WS_SELS) WSP(float, XB, WS_XB)
#undef WSP
};

template <int MODE  >
__device__ __forceinline__ void p0_transpose_item(const float* W, int K, int N, bf16* WT, LAS float* scr, int nblk, int item, int lane) {
    const int kb = item / nblk, nb = item % nblk, k0 = 64 * kb, n0 = 64 * nb;
    const int c4 = (lane & 15) * 4, kr = lane >> 4;
    int sc = n0 + c4;
    if (MODE == 1) { const int zc = sc; sc = zc < ZC_KV ? zc : (zc < ZC_BG ? zc + 24 : (zc < INW ? zc - ZC_BG + 4096 : -1)); }
    f32x4 v[16];
#pragma unroll
    for (int i = 0; i < 16; ++i) v[i] = sc >= 0 ? __builtin_nontemporal_load((const f32x4*)(W + (size_t)(k0 + 4 * i + kr) * N + sc)) : (f32x4){0.f, 0.f, 0.f, 0.f};
#pragma unroll
    for (int i = 0; i < 16; ++i) *(LAS f32x4*)(scr + (4 * i + kr) * 64 + (c4 ^ ((((4 * i + kr) >> 3) & 7) << 2))) = v[i];
    LDS_WAIT(); asm volatile("" ::: "memory");
    const int c = lane & 7;
#pragma unroll
    for (int j = 0; j < 8; ++j) { const int n = (lane >> 3) + 8 * j; const LAS float* s = scr + (8 * c) * 64 + (n ^ (c << 2));
        v4u o; o.x = cvtpk(s[0 * 64], s[1 * 64]); o.y = cvtpk(s[2 * 64], s[3 * 64]); o.z = cvtpk(s[4 * 64], s[5 * 64]); o.w = cvtpk(s[6 * 64], s[7 * 64]);
        *(v4u*)(WT + (size_t)(n0 + n) * K + k0 + 8 * c) = o; }
    LDS_WAIT(); asm volatile("" ::: "memory");
}
__device__ __forceinline__ void rms_row_to_bf16(const float* xrow, const float* g, bf16* orow, int lane) {
    const f32x4* xr = (const f32x4*)xrow + lane; const f32x4* gr = (const f32x4*)g + lane;
    f32x4 v[8]; float s = 0.f;
#pragma unroll
    for (int j = 0; j < 8; ++j) { v[j] = __builtin_nontemporal_load(xr + 64 * j); s += (v[j].x * v[j].x + v[j].y * v[j].y) + (v[j].z * v[j].z + v[j].w * v[j].w); }
    const float rstd = 1.0f / sqrtf(wave_sum(s) * (1.f / DM) + NORM_EPS);
    v2u* o8 = (v2u*)orow + lane;
#pragma unroll
    for (int j = 0; j < 8; ++j) { const f32x4 gg = gr[64 * j]; v2u w; w.x = cvtpk(v[j].x * rstd * gg.x, v[j].y * rstd * gg.y); w.y = cvtpk(v[j].z * rstd * gg.z, v[j].w * rstd * gg.w); o8[64 * j] = w; }
}
__device__ __forceinline__ void pool_sample(const Params& P, Frame& F, int k, int nidle, int NI) {
    LAS f32x4* red = (LAS f32x4*)F.lds;
    const int c4 = F.tid & 127, rg = F.tid >> 7;
    const int part = c4 >> 6, d = (c4 * 4) & 127;
    f32x4 av[16];
#pragma unroll
    for (int i = 0; i < 16; ++i) av[i] = *(const f32x4*)(P.a_cmp + ((size_t)part * 64 + rg + 4 * i) * 128 + d);
    f32x4 xa[16], xb[16];
#define POOL_LOAD(X, it) do { const int b_ = (it) >> 8, n_ = (it) & 255; const int page_ = P.page_table[b_ * NPAGES + (n_ >> 1)]; \
        const float* base_ = P.cache_kv + ((size_t)page_ * 128 + (n_ & 1) * 64 + rg) * 1024 + c4 * 4; \
        _Pragma("unroll") for (int i = 0; i < 16; ++i) X[i] = __builtin_nontemporal_load((const f32x4*)(base_ + (size_t)i * 4096)); } while (0)
#define POOL_REDUCE(X, it) do { f32x4 acc_ = (f32x4){0.f, 0.f, 0.f, 0.f}; _Pragma("unroll") for (int i = 0; i < 16; ++i) acc_ += av[i] * X[i]; \
        red[rg * 128 + c4] = acc_; __syncthreads(); \
        if (F.tid < 128) { const f32x4 s_ = (red[c4] + red[128 + c4]) + (red[256 + c4] + red[384 + c4]); *(f32x4*)(F.POOLS() + (size_t)(it) * 512 + c4 * 4) = s_; } \
        __syncthreads(); } while (0)
    int it = k;
    if (it < NI) POOL_LOAD(xa, it);
    while (it < NI) {
        const int it1 = it + nidle; if (it1 < NI) POOL_LOAD(xb, it1);
        POOL_REDUCE(xa, it);
        if (it1 >= NI) break;
        const int it2 = it1 + nidle; if (it2 < NI) POOL_LOAD(xa, it2);
        POOL_REDUCE(xb, it1);
        it = it2;
    }
#undef POOL_LOAD
#undef POOL_REDUCE
}
__device__ __forceinline__ void p0_prologue(const Params& P, Frame& F) {
    {
        LAS float* scr = (LAS float*)(F.lds + F.wave * 16384);
        constexpr int I_IN = (DM / 64) * (ZLD / 64), I_OUT = (DM / 64) * (DM / 64), I_MEM = (DM / 64) * (1024 / 64), I_T = I_IN + I_OUT + I_MEM, I_R = MPAD + 1024;
        constexpr int I_MIN = I_T < I_R ? I_T : I_R;
        LAS int* const pq = (LAS int*)(F.lds + 131072);
        int slot = 0;
        if (F.tid == 0) pq[0] = (int)atomicAdd(F.QUEUE() + 64 * 13, 1u);
        __syncthreads();
        for (;;) {
            const int base = pq[slot] * 16;
            if (base >= I_T + I_R) break;
            int nxt = 0; if (F.tid == 0) nxt = (int)atomicAdd(F.QUEUE() + 64 * 13, 1u);
            for (int it = base + 2 * F.wave; it < base + 2 * F.wave + 2 && it < I_T + I_R; ++it) {
                int kind, r;
                if (it < 2 * I_MIN) { kind = it & 1; r = it >> 1; } else { kind = I_T < I_R ? 1 : 0; r = it - I_MIN; }
                if (kind == 0) {
                    if (r < I_IN) p0_transpose_item<1>(P.w_in, DM, INW, F.WinT(), scr, ZLD / 64, r, F.lane);
                    else if (r < I_IN + I_OUT) p0_transpose_item<0>(P.w_out, DM, DM, F.WoutT(), scr, DM / 64, r - I_IN, F.lane);
                    else p0_transpose_item<0>(P.w_mem_kv, DM, 1024, F.WmemT(), scr, 1024 / 64, r - I_IN - I_OUT, F.lane);
                } else {
                    const int m = r;
                    if (m >= MALL && m < MPAD) { v4u z = (v4u){0u, 0u, 0u, 0u}; v4u* o = (v4u*)(F.HN() + (size_t)m * DM) + F.lane;
#pragma unroll
                        for (int j = 0; j < 4; ++j) o[64 * j] = z; }
                    else { const float* xr = m < MP ? P.x_prompt + (size_t)m * DM : (m < MALL ? P.x_sample + (size_t)(m - MP) * DM : P.mem_prompt + (size_t)(m - MPAD) * DM);
                           const float* gp = m < MALL ? P.norm_g : P.mem_norm_g; bf16* op = m < MALL ? F.HN() + (size_t)m * DM : F.HM() + (size_t)(m - MPAD) * DM;
                           rms_row_to_bf16(xr, gp, op, F.lane); }
                }
            }
            if (F.tid == 0) pq[slot ^ 1] = nxt;
            __syncthreads();
            slot ^= 1;
        }
    }
    {
        const int gt = F.vcu * NTHREADS + F.tid, NGT = F.G * NTHREADS;
        for (int i = gt; i < 2052 * 16; i += NGT) {
            const int pi = i >> 4, k = i & 15; const float pos = (float)(pi < PT ? pi : PAST + (pi - PT));
            const float fr = powf(500000.0f, -(float)k * (2.0f / 32.0f)); const float ang = pos * fr;
            float sn, cs; sincosf(ang, &sn, &cs); F.ROPE()[pi * 32 + k] = cs; F.ROPE()[pi * 32 + 16 + k] = sn;
        }
        constexpr int NCP = SBATCH * 508 * 128;
        for (int i = gt; i < NCP; i += NGT) { const int b = i / (508 * 128), r = i - b * (508 * 128);
            ((f32x4*)(P.out + OFF_WINS + (size_t)b * 512 * 512))[r] = ((const f32x4*)(P.cache_win + (size_t)b * 512 * 512 + 4 * 512))[r]; }
    }
}

__device__ __forceinline__ void p2_cmp_finalize(const Params& P, Frame& F) {
    const int gw = F.vcu * NWAVES + F.wave, NGW = F.G * NWAVES;
    constexpr int NP = PB * 32 * 4, NS = SBATCH * 256 * 4;
    { const int d = F.tid & 127, q0 = F.tid >> 7;
      f32x4 t[16];
#pragma unroll
      for (int i = 0; i < 16; ++i) { const int q = q0 + 4 * i; t[i] = *(const f32x4*)(P.w_cmp + ((size_t)(q >> 5) * 128 + d) * 128 + (q & 31) * 4); }
#pragma unroll
      for (int i = 0; i < 16; ++i) { const int q = q0 + 4 * i, prt = q >> 5, e4 = (q & 31) * 4;
#pragma unroll
          for (int x = 0; x < 4; ++x) { const int e = e4 + x;
              *(LAS unsigned short*)(F.lds + (prt * 128 + e) * 256 + ((((d >> 3) ^ (e & 15)) << 4) | ((d & 7) * 2))) = (unsigned short)(cvtpk(t[i][x], 0.f) & 0xffffu); } } }
    const int gt2 = F.vcu * NTHREADS + F.tid, NGT2 = F.G * NTHREADS;
    constexpr int NCW = SBATCH * 512 * 64, NCM = SBATCH * 256 * 128;
#define CW_SRC(i) (P.cache_win + ((((size_t)((i) >> 15) * 512 + (((i) >> 6) & 511)) * 2 + (((i) >> 5) & 1)) * 2 + (((i) >> 4) & 1)) * 128 + ((i) & 15) * 8)
#define CW_DST(i) (F.SWIN() + ((((size_t)((i) >> 15) * 2 + (((i) >> 4) & 1)) * 2 + (((i) >> 5) & 1)) * 512 + (((i) >> 6) & 511)) * 128 + ((i) & 15) * 8)
#define CM_SRC(i) (P.cache_mem + ((((size_t)((i) >> 15) * 256 + (((i) >> 7) & 255)) * 2 + (((i) >> 6) & 1)) * 4 + (((i) >> 4) & 3)) * 128 + ((i) & 15) * 8)
#define CM_DST(i) (F.SMB() + ((((size_t)((i) >> 15) * 4 + (((i) >> 4) & 3)) * 2 + (((i) >> 6) & 1)) * 256 + (((i) >> 7) & 255)) * 128 + ((i) & 15) * 8)
#define CV_STORE(dstp, a0, a1) do { v4u o_; o_.x = cvtpk(a0[0], a0[1]); o_.y = cvtpk(a0[2], a0[3]); o_.z = cvtpk(a1[0], a1[1]); o_.w = cvtpk(a1[2], a1[3]); *(v4u*)(dstp) = o_; } while (0)
    f32x4 cw[2][2], cm[2][2];
#pragma unroll
    for (int k = 0; k < 2; ++k) { const int i = gt2 + k * NGT2;
        if (i < NCW) { const float* sp = CW_SRC(i); cw[k][0] = __builtin_nontemporal_load((const f32x4*)sp); cw[k][1] = __builtin_nontemporal_load((const f32x4*)(sp + 4)); }
        if (i < NCM) { const float* sp = CM_SRC(i); cm[k][0] = __builtin_nontemporal_load((const f32x4*)sp); cm[k][1] = __builtin_nontemporal_load((const f32x4*)(sp + 4)); } }
    __syncthreads();
    for (int base = gw; base < NP + NS; base += 5 * NGW) {
        const int part = (base >> 1) & 1, n = F.lane & 31, k8 = F.lane >> 5;
        const int it = base + n * NGW; const bool ok = n < 5 && it < NP + NS;
        const float* src = it < NP ? F.POOLP() + (size_t)it * 128 : F.POOLS() + (size_t)(it - NP) * 128;
        f32x4 pv[8][2];
#pragma unroll
        for (int sk = 0; sk < 8; ++sk) { pv[sk][0] = ok ? *(const f32x4*)(src + 16 * sk + 8 * k8) : (f32x4){0.f, 0.f, 0.f, 0.f}; pv[sk][1] = ok ? *(const f32x4*)(src + 16 * sk + 8 * k8 + 4) : (f32x4){0.f, 0.f, 0.f, 0.f}; }
        f32x16 acc[4];
#pragma unroll
        for (int cb = 0; cb < 4; ++cb)
#pragma unroll
            for (int i = 0; i < 16; ++i) acc[cb][i] = 0.f;
#pragma unroll
        for (int sk = 0; sk < 8; ++sk) { v4u bw; bw.x = cvtpk(pv[sk][0][0], pv[sk][0][1]); bw.y = cvtpk(pv[sk][0][2], pv[sk][0][3]); bw.z = cvtpk(pv[sk][1][0], pv[sk][1][1]); bw.w = cvtpk(pv[sk][1][2], pv[sk][1][3]);
#pragma unroll
            for (int cb = 0; cb < 4; ++cb) { const int row = part * 128 + 32 * cb + n;
                const v4u aw = *(const LAS v4u*)(F.lds + row * 256 + ((((2 * sk + k8) ^ (row & 15))) << 4));
                acc[cb] = __builtin_amdgcn_mfma_f32_32x32x16_bf16(__builtin_bit_cast(bf16x8, aw), __builtin_bit_cast(bf16x8, bw), acc[cb], 0, 0, 0); } }
        if (ok) { bf16* dst;
            if (it < NP) { const int g = it & 1, nn = (it >> 2) & 31, b = it >> 7; dst = (part ? F.VCP() : F.KCP()) + ((size_t)(b * 2 + g) * 64 + nn) * 128; }
            else { const int i2 = it - NP; const int g = i2 & 1, nn = (i2 >> 2) & 255, b = i2 >> 10; dst = (part ? F.VCS() : F.KCS()) + ((size_t)(b * 2 + g) * 256 + nn) * 128; }
#pragma unroll
            for (int cb = 0; cb < 4; ++cb)
#pragma unroll
                for (int i = 0; i < 16; i += 2) *(unsigned*)(dst + 32 * cb + 8 * (i >> 2) + 4 * k8 + (i & 3)) = cvtpk(acc[cb][i], acc[cb][i + 1]); }
    }
#pragma unroll
    for (int k = 0; k < 2; ++k) { const int i = gt2 + k * NGT2;
        if (i < NCW) CV_STORE(CW_DST(i), cw[k][0], cw[k][1]);
        if (i < NCM) CV_STORE(CM_DST(i), cm[k][0], cm[k][1]); }
    for (int i = gt2 + 2 * NGT2; i < NCW; i += NGT2) { const float* sp = CW_SRC(i); const f32x4 x0 = __builtin_nontemporal_load((const f32x4*)sp), x1 = __builtin_nontemporal_load((const f32x4*)(sp + 4)); CV_STORE(CW_DST(i), x0, x1); }
    for (int i = gt2 + 2 * NGT2; i < NCM; i += NGT2) { const float* sp = CM_SRC(i); const f32x4 x0 = __builtin_nontemporal_load((const f32x4*)sp), x1 = __builtin_nontemporal_load((const f32x4*)(sp + 4)); CV_STORE(CM_DST(i), x0, x1); }
#undef CW_SRC
#undef CW_DST
#undef CM_SRC
#undef CM_DST
#undef CV_STORE
    const int gt = F.vcu * NTHREADS + F.tid, NGT = F.G * NTHREADS;
    for (int i = gt; i < 2 * PB * 2 * 32 * 16; i += NGT) {
        const int kv = i / (PB * 2 * 32 * 16), r = i % (PB * 2 * 32 * 16), bg = r / 512, w = r % 512;
        ((v4u*)((kv ? F.VCP() : F.KCP()) + ((size_t)bg * 64 + 32) * 128))[w] = (v4u){0u, 0u, 0u, 0u};
    }
}

namespace att {
constexpr float SCALE = 0.08838834764831845f, C2 = 1.4426950408889634f * SCALE, THR = 8.f;
constexpr int SHM_T = 16384;
constexpr int L_SD = 65536, L_IMP = L_SD + 32768, L_MISC = 131072, L_WSF = L_MISC, L_LIST = L_WSF + 4096, L_RMASK = L_LIST + 1536, L_ML = L_RMASK + 2112, L_CTRL = L_ML + 2048, L_SDS = L_CTRL + 64, L_IMPS = L_SDS + 4096, L_END = L_IMPS + 1024;
static_assert(L_END <= LDS_BYTES - 128, "attention LDS map");
constexpr int SNT = 1;
constexpr int U_SNSA = SBATCH * 2 * (STOK / SNT), U_PNSA = PB * 2 * (PT / 64), U_PMEM = PB * 4 * (PT / 256), U_SMEM = SBATCH * 4, U_CONV = (MALL + 31) / 32, U_SROW = DM / 32;
constexpr int U0_PNSA = U_SNSA, U0_PMEM = U0_PNSA + U_PNSA, U0_SMEM = U0_PMEM + U_PMEM, U0_CONV = U0_SMEM + U_SMEM, U0_SROW = U0_CONV + U_CONV, U_TOTAL = U0_SROW + U_SROW;
constexpr unsigned N_SAMPLE_PRODUCERS = U_SNSA + U_SMEM + 1;

#define KSWZ(row, colB) ((row) * 256 + ((colB) ^ (((row) & 7) << 4)))
#define SBAR() __builtin_amdgcn_sched_barrier(0)
__device__ __forceinline__ int v_st(int k, int c) { const int kk = (k & ~0xC) | ((k & 4) << 1) | ((k & 8) >> 1); return ((kk >> 3) * 4 + (c >> 5)) * 512 + ((kk & 7) * 32 + (c & 31)) * 2; }
__device__ __forceinline__ int v_rd_base(int lane) { return ((lane & 3) << 3) | (((lane >> 2) & 3) << 6) | (((lane >> 4) & 1) << 5) | (((lane >> 5) & 1) << 8); }
constexpr int v_rd_off(int d0, int ks, int half) { return d0 * 512 + ks * 4096 + half * 2048; }
__device__ __forceinline__ int crow(int r, int hi) { return (r & 3) + 8 * (r >> 2) + 4 * hi; }
__device__ __forceinline__ bf16x8 pack8(f32x4 a, f32x4 b) { v4u w = {cvtpk(a[0], a[1]), cvtpk(a[2], a[3]), cvtpk(b[0], b[1]), cvtpk(b[2], b[3])}; return __builtin_bit_cast(bf16x8, w); }

__device__ __forceinline__ void mask_tile(f32x16& p0, f32x16& p1, bool rowok, int pos, int kpos0, int kstride, unsigned W, int hi) {
    const float NEG = -__builtin_inff();
    const int dq = pos - kpos0 - 4 * hi * kstride;
#pragma unroll
    for (int r = 0; r < 16; ++r) {
        const int c = (r & 3) + 8 * (r >> 2);
        if (!(rowok && (unsigned)(dq - c * kstride) < W)) p0[r] = NEG;
        if (!(rowok && (unsigned)(dq - (c + 32) * kstride) < W)) p1[r] = NEG;
    }
}
__device__ __forceinline__ void partialSM(f32x16& p0, f32x16& p1, float& m_reg, float& mn, float& alpha) {
    float pmax = p0[0];
#pragma unroll
    for (int r = 1; r < 16; ++r) pmax = fmaxf(pmax, p0[r]);
#pragma unroll
    for (int r = 0; r < 16; ++r) pmax = fmaxf(pmax, p1[r]);
    { auto rr = __builtin_amdgcn_permlane32_swap(__float_as_uint(pmax), __float_as_uint(pmax), false, false);
      pmax = fmaxf(__uint_as_float(rr[0]), __uint_as_float(rr[1])); }
    if (__builtin_expect(__all((pmax - m_reg) * SCALE <= THR), 1)) { mn = m_reg; alpha = 1.f; }
    else { mn = fmaxf(m_reg, pmax); alpha = __builtin_amdgcn_exp2f((m_reg - mn) * C2); m_reg = mn; }
    const float mnL = -mn * C2;
#pragma unroll
    for (int r = 0; r < 16; ++r) p0[r] = fmaf(p0[r], C2, mnL);
#pragma unroll
    for (int r = 0; r < 16; ++r) p1[r] = fmaf(p1[r], C2, mnL);
#pragma unroll
    for (int r = 0; r < 16; ++r) p0[r] = __builtin_amdgcn_exp2f(p0[r]);
}
__device__ __forceinline__ void finishSM(f32x16& p0, f32x16& p1, float alpha, float& l_reg, bf16x8& pa0, bf16x8& pa1, bf16x8& pa2, bf16x8& pa3) {
#pragma unroll
    for (int r = 0; r < 16; ++r) p1[r] = __builtin_amdgcn_exp2f(p1[r]);
    float ps = 0;
#pragma unroll
    for (int r = 0; r < 16; ++r) ps += p0[r];
#pragma unroll
    for (int r = 0; r < 16; ++r) ps += p1[r];
    { auto rr = __builtin_amdgcn_permlane32_swap(__float_as_uint(ps), __float_as_uint(ps), false, false);
      ps = __uint_as_float(rr[0]) + __uint_as_float(rr[1]); }
    l_reg = l_reg * alpha + ps;
#define PK4(P, B_, OUT) do { unsigned a0 = cvtpk(P[B_+0], P[B_+1]), a1 = cvtpk(P[B_+2], P[B_+3]);                          \
        unsigned b0 = cvtpk(P[B_+4], P[B_+5]), b1 = cvtpk(P[B_+6], P[B_+7]);                                             \
        auto r0 = __builtin_amdgcn_permlane32_swap(a0, b0, false, false); auto r1 = __builtin_amdgcn_permlane32_swap(a1, b1, false, false); \
        v4u w = {r0[0], r1[0], r0[1], r1[1]}; OUT = __builtin_bit_cast(bf16x8, w); } while (0)
    PK4(p0, 0, pa0); PK4(p0, 8, pa1); PK4(p1, 0, pa2); PK4(p1, 8, pa3);
#undef PK4
}
__device__ __forceinline__ void qkt(f32x16& p0, f32x16& p1, const lbyte* Kt, int r32, int hi, const bf16x8* qr) {
    p0 = f32x16{}; p1 = f32x16{};
    const lbyte* kb[4];
#pragma unroll
    for (int dd = 0; dd < 4; ++dd) kb[dd] = Kt + KSWZ(r32, (dd * 16 + hi * 8) * 2);
    bf16x8 fa0, fa1, fb0, fb1;
#define LDK(F0, F1, d0) do { const lbyte* a_ = kb[(d0) & 3] + ((d0) >> 2) * 128; F0 = *(const LAS bf16x8*)(a_); F1 = *(const LAS bf16x8*)(a_ + 32 * 256); } while (0)
#define MMK(F0, F1, d0) do { p0 = __builtin_amdgcn_mfma_f32_32x32x16_bf16(F0, qr[(d0)], p0, 0, 0, 0); p1 = __builtin_amdgcn_mfma_f32_32x32x16_bf16(F1, qr[(d0)], p1, 0, 0, 0); } while (0)
    LDK(fa0, fa1, 0); LDK(fb0, fb1, 1); SBAR();
    MMK(fa0, fa1, 0); SBAR(); LDK(fa0, fa1, 2); SBAR();
    MMK(fb0, fb1, 1); SBAR(); LDK(fb0, fb1, 3); SBAR();
    MMK(fa0, fa1, 2); SBAR(); LDK(fa0, fa1, 4); SBAR();
    MMK(fb0, fb1, 3); SBAR(); LDK(fb0, fb1, 5); SBAR();
    MMK(fa0, fa1, 4); SBAR(); LDK(fa0, fa1, 6); SBAR();
    MMK(fb0, fb1, 5); SBAR(); LDK(fb0, fb1, 7); SBAR();
    MMK(fa0, fa1, 6); MMK(fb0, fb1, 7);
#undef LDK
#undef MMK
}
__device__ __forceinline__ void pv_tile(f32x16* o, int vb, bf16x8 pa0, bf16x8 pa1, bf16x8 pa2, bf16x8 pa3) {
#define TRRD(dst, off) asm volatile("ds_read_b64_tr_b16 %0, %1 offset:%2" : "=&v"(dst) : "v"(vb), "i"(off) : "memory")
#define PV_D0(d0) do { s16x4 l0, l1, l2, l3, h0, h1, h2, h3; constexpr int b_ = v_rd_off(d0, 0, 0); \
        TRRD(l0, b_); TRRD(h0, b_ + 2048); TRRD(l1, b_ + 4096); TRRD(h1, b_ + 6144); TRRD(l2, b_ + 8192); TRRD(h2, b_ + 10240); TRRD(l3, b_ + 12288); TRRD(h3, b_ + 14336); \
        asm volatile("s_waitcnt lgkmcnt(0)" ::: "memory"); SBAR(); \
        o[d0] = __builtin_amdgcn_mfma_f32_32x32x16_bf16(pa0, (bf16x8){l0[0], l0[1], l0[2], l0[3], h0[0], h0[1], h0[2], h0[3]}, o[d0], 0, 0, 0);   \
        o[d0] = __builtin_amdgcn_mfma_f32_32x32x16_bf16(pa1, (bf16x8){l1[0], l1[1], l1[2], l1[3], h1[0], h1[1], h1[2], h1[3]}, o[d0], 0, 0, 0);   \
        o[d0] = __builtin_amdgcn_mfma_f32_32x32x16_bf16(pa2, (bf16x8){l2[0], l2[1], l2[2], l2[3], h2[0], h2[1], h2[2], h2[3]}, o[d0], 0, 0, 0);   \
        o[d0] = __builtin_amdgcn_mfma_f32_32x32x16_bf16(pa3, (bf16x8){l3[0], l3[1], l3[2], l3[3], h3[0], h3[1], h3[2], h3[3]}, o[d0], 0, 0, 0); } while (0)
    PV_D0(0); PV_D0(1); PV_D0(2); PV_D0(3);
#undef PV_D0
#undef TRRD
}

struct TileSrc { const char* kp; const char* vp; int strideB; int f32; int kpos0; int nvalid; unsigned mlo, mhi; };

__device__ __forceinline__ TileSrc tile_src(const Params& P, const Frame& F, int sample, int bk, int b, int gh, int j, int e, int su) {
    TileSrc s; s.nvalid = 64; s.f32 = 0; s.mlo = 0xffffffffu; s.mhi = 0xffffffffu;
    if (!sample) {
        if (bk == 0) { const size_t o = ((size_t)(b * 2 + gh) * 64) * 128 * 2; s.kp = (const char*)F.KCP() + o; s.vp = (const char*)F.VCP() + o; s.strideB = 256; s.kpos0 = 63; }
        else if (bk == 3) { const size_t o = (((size_t)b * 256 + j * 64) * 1024 + gh * 128) * 2; s.kp = (const char*)F.MKV() + o; s.vp = s.kp + 512 * 2; s.strideB = 2048; s.kpos0 = 0; }
        else { const int kind = bk == 1 ? 0 : 2; const size_t o = ((size_t)(kind * 8 + b * 2 + gh) * PT + j * 64) * 128 * 2;
               s.kp = (const char*)F.KV4() + o; s.vp = s.kp + (size_t)8 * PT * 128 * 2; s.strideB = 256; s.kpos0 = j * 64; }
    } else {
        if (bk == 0) { const size_t o = (((size_t)(b * 2 + gh) * 256 + j * 64) * 128) * 2; s.kp = (const char*)F.KCS() + o; s.vp = (const char*)F.VCS() + o; s.strideB = 256; s.kpos0 = j * 4096 + 63; }
        else if (bk == 3) { const size_t o = ((((size_t)b * 4 + gh) * 2) * 256 + j * 64) * 128 * 2; s.kp = (const char*)F.SMB() + o; s.vp = s.kp + (size_t)256 * 128 * 2; s.strideB = 256; s.kpos0 = 0; }
        else if (bk == 1 && j < 256) { const size_t o = ((size_t)su * 17 + e) * (2 * 64 * 128) * 2; s.kp = (const char*)F.SELS() + o; s.vp = s.kp + 64 * 128 * 2; s.strideB = 256; s.kpos0 = j * 64; }
        else if (bk == 2 && j < 8) { const size_t o = ((((size_t)b * 2 + gh) * 2) * 512 + j * 64) * 128 * 2; s.kp = (const char*)F.SWIN() + o; s.vp = s.kp + (size_t)512 * 128 * 2; s.strideB = 256; s.kpos0 = (PAST - 512) + j * 64; }
        else { const int part = bk == 1 ? 2 : 4; const size_t o = (((size_t)MP + b * 4) * ZLD + ZC_KV + part * 256 + gh * 128) * 2;
               s.kp = (const char*)F.Z() + o; s.vp = s.kp + 256 * 2; s.strideB = ZLD * 2; s.kpos0 = PAST; s.nvalid = 4; }
    }
    return s;
}

constexpr int SV_QS = 0, SV_S = 2048, SV_R = SV_S + 16384, SV_LM = SV_R + 32768, SV_CS = SV_LM + 64, SV_END = SV_CS + 2048;
__device__ __forceinline__ void sample_sel_valu(const Params& P, const Frame& F, int b, int g, int t, int n, lbyte* lds, int tid) {
    LAS float* const Qs = (LAS float*)(lds + SV_QS); LAS float* const S = (LAS float*)(lds + SV_S); LAS float* const R = (LAS float*)(lds + SV_R);
    LAS float* const LM = (LAS float*)(lds + SV_LM); LAS float* const CS = (LAS float*)(lds + SV_CS);
    LAS const int* const LISTc = (LAS const int*)(lds + L_LIST);
    asm volatile("" : "+v"(tid));
    const int row = MP + b * 4 + t, lane = tid & 63, wv = tid >> 6;
    { const int h = tid >> 7, d = tid & 127; Qs[h * 128 + d] = bf2f(F.Z()[(size_t)row * ZLD + ZC_Q + (g * 4 + h) * 128 + d]); }
    __syncthreads();
    { const int kk = tid >> 3, p8 = tid & 7;
      for (int e0 = 0; e0 < n; e0 += 4) {
          f32x4 kv[4][4]; int jj[4];
#pragma unroll
          for (int u = 0; u < 4; ++u) { const int e = e0 + u < n ? e0 + u : n - 1; const int j = __builtin_amdgcn_readfirstlane(LISTc[3 * e]); jj[u] = j;
              if (j < 256) { const int page = P.page_table[b * NPAGES + (j >> 1)];
                  const float* kp = P.cache_kv + ((size_t)page * 128 + (j & 1) * 64 + kk) * 1024 + 2 * 256 + g * 128 + p8 * 16;
#pragma unroll
                  for (int i = 0; i < 4; ++i) kv[u][i] = *(const f32x4*)(kp + 4 * i); }
              else { const bf16* kp = F.Z() + (size_t)(MP + b * 4 + (kk < 4 ? kk : 0)) * ZLD + ZC_KV + 2 * 256 + g * 128 + p8 * 16;
                  const v4u w0 = *(const v4u*)kp, w1 = *(const v4u*)(kp + 8);
#pragma unroll
                  for (int i = 0; i < 2; ++i) { kv[u][i] = (f32x4){__uint_as_float(w0[2 * i] << 16), __uint_as_float(w0[2 * i] & 0xffff0000u), __uint_as_float(w0[2 * i + 1] << 16), __uint_as_float(w0[2 * i + 1] & 0xffff0000u)};
                                                kv[u][2 + i] = (f32x4){__uint_as_float(w1[2 * i] << 16), __uint_as_float(w1[2 * i] & 0xffff0000u), __uint_as_float(w1[2 * i + 1] << 16), __uint_as_float(w1[2 * i + 1] & 0xffff0000u)}; } } }
#pragma unroll
          for (int u = 0; u < 4; ++u) if (e0 + u < n) { const int e = e0 + u, j = jj[u];
              float sc[4];
#pragma unroll
              for (int h = 0; h < 4; ++h) { const LAS f32x4* qh = (const LAS f32x4*)(Qs + h * 128 + p8 * 16); f32x4 a = qh[0] * kv[u][0] + qh[1] * kv[u][1] + qh[2] * kv[u][2] + qh[3] * kv[u][3]; float x = (a[0] + a[1]) + (a[2] + a[3]);
                  x += __shfl_xor(x, 1); x += __shfl_xor(x, 2); x += __shfl_xor(x, 4); sc[h] = x; }
              if (p8 == 0) { const bool ok = j < 256 || kk <= t;
#pragma unroll
                  for (int h = 0; h < 4; ++h) S[h * 1024 + e * 64 + kk] = ok ? sc[h] * SCALE : -__builtin_inff(); } } } }
    __syncthreads();
    if (wv < 4) { const int NK = n * 64; LAS float* Sh = S + wv * 1024; float m = -__builtin_inff();
        for (int k = lane; k < NK; k += 64) m = fmaxf(m, Sh[k]);
#pragma unroll
        for (int o = 1; o < 64; o <<= 1) m = fmaxf(m, __shfl_xor(m, o));
        float l = 0.f;
        for (int k = lane; k < NK; k += 64) { const float p = __builtin_amdgcn_exp2f((Sh[k] - m) * 1.4426950408889634f); Sh[k] = p; l += p; }
        l = wave_sum(l); if (lane == 0) LM[wv] = l; }
    __syncthreads();
    { const int d4 = tid & 31, kg = tid >> 5;
      f32x4 acc[4];
#pragma unroll
      for (int h = 0; h < 4; ++h) acc[h] = (f32x4){0.f, 0.f, 0.f, 0.f};
      for (int e0 = 0; e0 < n; e0 += 4) {
          f32x4 vv[4][4];
#pragma unroll
          for (int u = 0; u < 4; ++u) { const int e = e0 + u < n ? e0 + u : n - 1; const int j = __builtin_amdgcn_readfirstlane(LISTc[3 * e]);
              if (j < 256) { const int page = P.page_table[b * NPAGES + (j >> 1)];
                  const float* vp = P.cache_kv + ((size_t)page * 128 + (j & 1) * 64 + kg) * 1024 + 3 * 256 + g * 128 + d4 * 4;
#pragma unroll
                  for (int q = 0; q < 4; ++q) vv[u][q] = *(const f32x4*)(vp + (size_t)q * 16 * 1024); }
              else {
#pragma unroll
                  for (int q = 0; q < 4; ++q) { const int key = kg + 16 * q; vv[u][q] = (f32x4){0.f, 0.f, 0.f, 0.f};
                      if (key < 4) { const v2u w = *(const v2u*)(F.Z() + (size_t)(MP + b * 4 + key) * ZLD + ZC_KV + 3 * 256 + g * 128 + d4 * 4);
                          vv[u][q] = (f32x4){__uint_as_float(w[0] << 16), __uint_as_float(w[0] & 0xffff0000u), __uint_as_float(w[1] << 16), __uint_as_float(w[1] & 0xffff0000u)}; } } } }
#pragma unroll
          for (int u = 0; u < 4; ++u) if (e0 + u < n) { const int e = e0 + u;
#pragma unroll
              for (int q = 0; q < 4; ++q)
#pragma unroll
                  for (int h = 0; h < 4; ++h) acc[h] += S[h * 1024 + e * 64 + kg + 16 * q] * vv[u][q]; } }
#pragma unroll
      for (int h = 0; h < 4; ++h) *(LAS f32x4*)(R + (kg * 4 + h) * 128 + d4 * 4) = acc[h]; }
    __syncthreads();
    { const int h = tid >> 7, d = tid & 127; float o = 0.f;
#pragma unroll
      for (int kg = 0; kg < 16; ++kg) o += R[(kg * 4 + h) * 128 + d];
      const float gate = 1.0f / (1.0f + __expf(-bf2f(F.Z()[(size_t)row * ZLD + ZC_BG + (g * 4 + h) * 3 + 1])));
      CS[h * 128 + d] = gate * o / LM[h]; }
    __syncthreads();
}

__device__ __forceinline__ void attn_unit(const Params& P, const Frame& F0, int kind, int b, int gh, int t0, int nth, int nt) {
    Frame F = F0; asm volatile("" : "+s"(F.ws));
    int tid = F.wave * 64 + (int)__builtin_amdgcn_mbcnt_hi(~0u, __builtin_amdgcn_mbcnt_lo(~0u, 0u)); asm volatile("" : "+v"(tid));
    const int lane = tid & 63, wid = F.wave, r32 = lane & 31, hi = lane >> 5, w4 = wid & 3, half = wid >> 2;
    const bool nsa = kind < 2; const int sample = kind & 1;
    lbyte* const lds = F.lds;
    LAS float* const wsf = (LAS float*)(lds + L_WSF) + wid * 128;
    LAS int* const LIST = (LAS int*)(lds + L_LIST);
    LAS unsigned* const RMASK = (LAS unsigned*)(lds + L_RMASK);
    LAS float* const ML = (LAS float*)(lds + L_ML);
    LAS float* const IMP = (LAS float*)(lds + (sample ? L_IMPS : L_IMP));
    LAS float* const SD = (LAS float*)(lds + (sample ? L_SDS : L_SD));
    LAS int* const CTRL = (LAS int*)(lds + L_CTRL);
    unsigned totp[4][8];
#pragma unroll
    for (int d0 = 0; d0 < 4; ++d0)
#pragma unroll
        for (int q = 0; q < 8; ++q) totp[d0][q] = 0u;

    const int wrow0 = nsa ? half * nth : wid * 32;
    const int tokidx = wrow0 + r32;
    const bool valid = r32 < nth && tokidx < nt;
    const int su = (b * 2 + gh) * 4 + t0;
#define ROWOK(rw) ((rw) < nth && wrow0 + (rw) < nt)
    const int rowbase = sample ? MP + b * 4 + t0 : b * PT + t0;
    const int grow = rowbase + (valid ? tokidx : 0);
    const int pos = (sample ? PAST + t0 : t0) + tokidx;
    const int head = nsa ? gh * 4 + w4 : gh;
    const int qcol = nsa ? ZC_Q + head * 128 : ZC_MQ + head * 128;
    const int g2col = nsa ? ZC_NG + head * 128 : ZC_MG + head * 128;
    const int mixcol = nsa ? 512 + head * 128 : 1536 + head * 128;
    const int cur = sample ? 256 : (t0 >> 6);
    const unsigned vmask = nth >= 32 ? 0xffffffffu : ((1u << nth) - 1u);
    const bool allvalid = nth >= 32 && wrow0 + 32 <= nt;

#define PT0(id) unsigned long long pt0_##id = 0; if (PROBE_PHASE == (id) && sample) pt0_##id = __builtin_amdgcn_s_memrealtime()
#define PT1(id) do { if (PROBE_PHASE == (id) && sample && threadIdx.x == 0) { volatile LAS unsigned long long* tacc = (volatile LAS unsigned long long*)(lds + LDS_BYTES - 128 + 16) + 7; *tacc = *tacc + (__builtin_amdgcn_s_memrealtime() - pt0_##id); } } while (0)
    unsigned long long pq0_ = 0; if (PROBE_PHASE == 64 && kind == 0) pq0_ = __builtin_amdgcn_s_memrealtime();
    bf16x8 qr[8];
    { const bf16* qp = F.Z() + (size_t)grow * ZLD + qcol + hi * 8;
#pragma unroll
      for (int d0 = 0; d0 < 8; ++d0) qr[d0] = *(const bf16x8*)(qp + d0 * 16); }
    if (PROBE_PHASE == 64 && kind == 0) { asm volatile("s_waitcnt vmcnt(0)" ::: "memory"); if (threadIdx.x == 0) { volatile LAS unsigned long long* tacc = (volatile LAS unsigned long long*)(lds + LDS_BYTES - 128 + 16) + 7; *tacc = *tacc + (__builtin_amdgcn_s_memrealtime() - pq0_); } }

    if (kind == 1) {
        const v4u* w0 = (const v4u*)(F.KCS() + (size_t)(b * 2 + gh) * 256 * 128); const v4u* w1 = (const v4u*)(F.VCS() + (size_t)(b * 2 + gh) * 256 * 128);
        const v4u* w2 = (const v4u*)(F.SWIN() + (size_t)(b * 2 + gh) * 2 * 512 * 128);
        v4u acc_ = (v4u){0u, 0u, 0u, 0u};
#pragma unroll
        for (int i = 0; i < 8; ++i) { acc_ |= w0[tid + 512 * i]; acc_ |= w1[tid + 512 * i]; }
#pragma unroll 8
        for (int i = 0; i < 32; ++i) acc_ |= w2[tid + 512 * i];
        asm volatile("" :: "v"(acc_));
    }
    const int nbr = nsa ? 3 : 1;
    int pre_b = -1;
    for (int br = 0; br < nbr; ++br) {
        const int bk = nsa ? br : 3;
        int ntiles, jlo = 0, listmode = 0, kstride = 1; unsigned W = 0x7fffffffu;
        if (bk == 0) { ntiles = sample ? 4 : 1; kstride = 64; }
        else if (bk == 1) { ntiles = CTRL[1]; listmode = 1; }
        else if (bk == 2) { W = 512u; if (sample) { ntiles = 9; } else { const int lo = t0 - 511; jlo = lo > 0 ? (lo >> 6) : 0; ntiles = ((t0 + nt - 1) >> 6) - jlo + 1; } }
        else { ntiles = 4; kstride = 0; }
        ntiles = __builtin_amdgcn_readfirstlane(ntiles);
        if (nsa && bk <= 1) {
            if (bk == 0) { const bf16* qp = F.QNR() + ((size_t)grow * 8 + head) * 32 + hi * 8; qr[0] = *(const bf16x8*)qp; qr[1] = *(const bf16x8*)(qp + 16); }
            else { const bf16* qp = F.Z() + (size_t)grow * ZLD + qcol + hi * 8; qr[0] = *(const bf16x8*)qp; qr[1] = *(const bf16x8*)(qp + 16); }
        }
        if (sample && bk == 1) continue;
        const float gate = nsa ? 1.0f / (1.0f + __expf(-bf2f(F.Z()[(size_t)grow * ZLD + ZC_BG + head * 3 + br]))) : 1.0f;
        const bool dump = nsa && bk == 0;
        const int dumpNK = sample ? 256 : 32;

        float m_reg = -1e30f, l_reg = 0.f; f32x16 o[4];
#pragma unroll
        for (int d0 = 0; d0 < 4; ++d0) o[d0] = f32x16{};

#define GET_ENTRY(e, J, ML_, MH_) do { if (listmode) { J = __builtin_amdgcn_readfirstlane(LIST[3 * (e)]); ML_ = (unsigned)__builtin_amdgcn_readfirstlane(LIST[3 * (e) + 1]); MH_ = (unsigned)__builtin_amdgcn_readfirstlane(LIST[3 * (e) + 2]); } else { J = jlo + (e); ML_ = 0xffffffffu; MH_ = 0xffffffffu; } } while (0)
#define STAGE_DMA(S_, bf) do { lbyte* Kt_ = lds + (bf) * (2 * SHM_T); lbyte* Vt_ = Kt_ + SHM_T; int l_ = lane; asm volatile("" : "+v"(l_));   \
        const int dk_row = l_ >> 4, dk_c0 = (l_ & 15) ^ (l_ >> 4), dv_kk = (l_ & 31) >> 2, dv_c = (l_ & 3) * 8; \
        _Pragma("unroll") for (int i_ = 0; i_ < 2; ++i_) { const int q_ = wid * 2 + i_; \
            __builtin_amdgcn_global_load_lds((const unsigned*)((S_).kp + (size_t)(q_ * 4 + dk_row) * (S_).strideB + ((dk_c0 ^ ((i_ & 1) << 2)) * 16)), (LAS unsigned*)(Kt_ + q_ * 1024), 16, 0, 0); \
            const int st_ = 2 * q_ + (l_ >> 5); const int kk_ = (st_ >> 2) * 8 + dv_kk; const int k_ = (kk_ & ~0xC) | ((kk_ & 4) << 1) | ((kk_ & 8) >> 1); \
            __builtin_amdgcn_global_load_lds((const unsigned*)((S_).vp + (size_t)k_ * (S_).strideB + ((st_ & 3) * 32 + dv_c) * 2), (LAS unsigned*)(Vt_ + q_ * 1024), 16, 0, 0); } } while (0)
#define STAGE_PART(S_, bf) do { lbyte* Kt_ = lds + (bf) * (2 * SHM_T); lbyte* Vt_ = Kt_ + SHM_T; int t_ = tid; asm volatile("" : "+v"(t_)); const int sr = t_ >> 4, sc = (t_ & 15) * 8; \
        _Pragma("unroll") for (int i_ = 0; i_ < 2; ++i_) { const int row_ = sr + 32 * i_; bf16x8 k_ = bf16x8{}, v_ = bf16x8{}; \
            if (row_ < (S_).nvalid) { k_ = *(const bf16x8*)((S_).kp + (size_t)row_ * (S_).strideB + sc * 2); v_ = *(const bf16x8*)((S_).vp + (size_t)row_ * (S_).strideB + sc * 2); } \
            *(LAS bf16x8*)(Kt_ + KSWZ(row_, sc * 2)) = k_; *(LAS bf16x8*)(Vt_ + v_st(row_, sc)) = v_; } } while (0)
#define IS_DMA(S_) ((S_).nvalid == 64)
#define EMPTY_SRC(S_) do { (S_).kpos0 = 0; (S_).mlo = 0u; (S_).mhi = 0u; (S_).f32 = 0; (S_).nvalid = 64; (S_).kp = nullptr; (S_).vp = nullptr; (S_).strideB = 0; } while (0)
#define FETCH_SRC(S_, e_) do { int j_; unsigned ml_, mh_; GET_ENTRY((e_), j_, ml_, mh_); (S_) = tile_src(P, F, sample, bk, b, gh, j_, (e_), su); (S_).mlo = ml_; (S_).mhi = mh_; } while (0)
        TileSrc cs0, cs1; EMPTY_SRC(cs0); EMPTY_SRC(cs1);
        const int boff = pre_b >= 0 ? pre_b : 0;
        if (pre_b >= 0) { FETCH_SRC(cs0, 0); if (ntiles > 1) FETCH_SRC(cs1, 1); pre_b = -1; }
        else {
        if (ntiles > 0) { FETCH_SRC(cs0, 0); if (IS_DMA(cs0)) { STAGE_DMA(cs0, 0); } else { STAGE_PART(cs0, 0); } }
        if (ntiles > 1) { FETCH_SRC(cs1, 1); if (IS_DMA(cs1)) { STAGE_DMA(cs1, 1); } else { STAGE_PART(cs1, 1); } }
        asm volatile("s_waitcnt vmcnt(0)" ::: "memory");
        __syncthreads();
        }
        unsigned long long tl0_ = 0; if (PROBE_PHASE == 10) tl0_ = __builtin_amdgcn_s_memrealtime();
        PT0(40);
        const int nsteps = (ntiles + 1) >> 1;
        for (int s2 = 0; s2 < nsteps; ++s2) {
            const int base = 2 * s2, bb = ((s2 & 1) * 2) ^ boff, nb = 2 - bb;
            const bool h0 = base + 2 < ntiles, h1 = base + 3 < ntiles;
            const bool prew = kind == 0 && bk == 1 && s2 == nsteps - 1;
            TileSrc ns0, ns1; EMPTY_SRC(ns0); EMPTY_SRC(ns1);
#define NEXT_TILES() do { if (h0) { FETCH_SRC(ns0, base + 2); if (IS_DMA(ns0)) { STAGE_DMA(ns0, nb); } } if (h1) { FETCH_SRC(ns1, base + 3); if (IS_DMA(ns1)) { STAGE_DMA(ns1, nb + 1); } } \
                if (prew) { const int lo_ = t0 - 511, jw_ = lo_ > 0 ? (lo_ >> 6) : 0, nw_ = ((t0 + nt - 1) >> 6) - jw_ + 1; \
                    TileSrc w0_ = tile_src(P, F, 0, 2, b, gh, jw_, 0, su); STAGE_DMA(w0_, nb); \
                    if (nw_ > 1) { TileSrc w1_ = tile_src(P, F, 0, 2, b, gh, jw_ + 1, 1, su); STAGE_DMA(w1_, nb + 1); } } } while (0)
#define COMPUTE_TILE(C_, BUF_, AFTER_QK) do { \
                const lbyte* Kt = lds + (BUF_) * (2 * SHM_T); \
                f32x16 p0, p1; float mn, alpha; bf16x8 pa0, pa1, pa2, pa3; \
                qkt(p0, p1, Kt, r32, hi, qr); \
                SBAR(); AFTER_QK; SBAR(); \
                { const unsigned rm = half ? (C_).mhi : (C_).mlo; const unsigned rmm = nsa ? rm : 0xffffffffu; \
                  const int pmin = (sample ? PAST + t0 : t0) + wrow0, kmax = (C_).kpos0 + 63 * kstride; \
                  const bool full = allvalid && rmm == 0xffffffffu && kmax <= pmin && (long long)(C_).kpos0 > (long long)pmin + 31 - (long long)W; \
                  if (!full) mask_tile(p0, p1, valid && ((rmm >> (r32 & 31)) & 1u), pos, (C_).kpos0, kstride, W, hi); } \
                if (dump && valid) { const int key0 = (sample ? (((C_).kpos0 - 63) >> 6) : 0); \
                    _Pragma("unroll") for (int r = 0; r < 16; ++r) { const int kk = key0 + crow(r, hi); \
                        if (kk < dumpNK) SD[(w4 * nt + tokidx) * dumpNK + kk] = p0[r]; \
                        if (kk + 32 < dumpNK) SD[(w4 * nt + tokidx) * dumpNK + kk + 32] = p1[r]; } } \
                partialSM(p0, p1, m_reg, mn, alpha); \
                finishSM(p0, p1, alpha, l_reg, pa0, pa1, pa2, pa3); \
                if (__any(alpha < 1.f)) { if (hi == 0) wsf[r32] = alpha; LDS_WAIT(); \
                    _Pragma("unroll") for (int r = 0; r < 16; ++r) { const float a = wsf[crow(r, hi)]; \
                        _Pragma("unroll") for (int d0 = 0; d0 < 4; ++d0) o[d0][r] *= a; } } \
                { int lv_ = lane; asm volatile("" : "+v"(lv_)); pv_tile(o, (int)(unsigned)(uintptr_t)(Kt + SHM_T) + v_rd_base(lv_), pa0, pa1, pa2, pa3); } } while (0)
            if (wrow0 < nt) {
                COMPUTE_TILE(cs0, bb, NEXT_TILES());
                if (base + 1 < ntiles) { COMPUTE_TILE(cs1, bb + 1, (void)0); }
            }
            else { NEXT_TILES(); }
#undef NEXT_TILES
#undef COMPUTE_TILE
            if (h0 && !IS_DMA(ns0)) { STAGE_PART(ns0, nb); }
            if (h1 && !IS_DMA(ns1)) { STAGE_PART(ns1, nb + 1); }
            cs0 = ns0; cs1 = ns1;
            if (prew) pre_b = nb;
            asm volatile("s_waitcnt vmcnt(0)" ::: "memory");
            __syncthreads();
        }
#undef EMPTY_SRC
#undef FETCH_SRC
        if ((PROBE_PHASE == 10 || PROBE_PHASE == 13) && threadIdx.x == 0) { volatile LAS unsigned long long* tacc = (volatile LAS unsigned long long*)(lds + LDS_BYTES - 128 + 16) + 7; *tacc = *tacc + (PROBE_PHASE == 10 ? (__builtin_amdgcn_s_memrealtime() - tl0_) : (unsigned long long)ntiles * 100ull); }
        PT1(40);
#undef GET_ENTRY
#undef STAGE_DMA
#undef STAGE_PART
#undef IS_DMA
        const float inv = l_reg > 0.f ? 1.0f / l_reg : 0.f;
        if (dump) {
            PT0(42);
            if (hi == 0 && valid) { ML[(w4 * nt + tokidx) * 2] = m_reg; ML[(w4 * nt + tokidx) * 2 + 1] = inv; }
            __syncthreads();
            const int total = nt * dumpNK;
            for (int idx = tid; idx < total; idx += NTHREADS) { const int t = idx / dumpNK, j = idx - t * dumpNK; float sacc = 0.f;
#pragma unroll
                for (int w = 0; w < 4; ++w) { const float sc_ = SD[(w * nt + t) * dumpNK + j]; sacc += __builtin_amdgcn_exp2f((sc_ - ML[(w * nt + t) * 2]) * C2) * ML[(w * nt + t) * 2 + 1]; }
                IMP[idx] = sacc; }
            for (int j = tid; j < 2 * 264; j += NTHREADS) { const int jj = j >= 264 ? j - 264 : j; RMASK[j] = (jj <= cur && (jj == 0 || jj == cur || jj == cur - 1)) ? vmask : 0u; }
            __syncthreads();
            const int nforced = cur == 0 ? 1 : (cur == 1 ? 2 : 3), ksel = 16 - nforced;
            for (int idx = tid; idx < total; idx += NTHREADS) { const int t = idx / dumpNK, j = idx - t * dumpNK;
                if (j >= 1 && j <= cur - 2) { const float v = IMP[idx]; int rank = 0;
                    for (int i4 = 0; i4 <= cur - 2; i4 += 4) { const f32x4 x = *(const LAS f32x4*)(IMP + t * dumpNK + i4);
#pragma unroll
                        for (int e = 0; e < 4; ++e) { const int i = i4 + e; rank += (i >= 1 && i <= cur - 2 && (x[e] > v || (x[e] == v && i < j))) ? 1 : 0; } }
                    if (rank < ksel) __hip_atomic_fetch_or(&RMASK[(t / nth) * 264 + j], 1u << (t % nth), __ATOMIC_RELAXED, __HIP_MEMORY_SCOPE_WORKGROUP); } }
            __syncthreads();
            if (wid == 0) { int n = 0;
                for (int base = 0; base <= cur; base += 64) { const int j = base + lane; const unsigned rl = j <= cur ? RMASK[j] : 0u, rh = j <= cur ? RMASK[264 + j] : 0u; const bool has = (rl | rh) != 0u;
                    const unsigned long long bal = __ballot(has);
                    if (has) { const int ix = n + __popcll(bal & ((1ull << lane) - 1ull)); LIST[3 * ix] = j; LIST[3 * ix + 1] = (int)rl; LIST[3 * ix + 2] = (int)rh; }
                    n += __popcll(bal); }
                if (lane == 0) CTRL[1] = n; }
            __syncthreads();
            PT1(42);
        }
        if (hi == 0) wsf[r32] = gate * inv;
        LDS_WAIT();
        {
#pragma unroll
        for (int q = 0; q < 8; ++q) { const float c0 = wsf[crow(2 * q, hi)], c1 = wsf[crow(2 * q + 1, hi)];
#pragma unroll
            for (int d0 = 0; d0 < 4; ++d0) { float v0 = c0 * o[d0][2 * q], v1 = c1 * o[d0][2 * q + 1];
                { const unsigned tp = totp[d0][q]; v0 += __uint_as_float(tp << 16); v1 += __uint_as_float(tp & 0xffff0000u); }
                totp[d0][q] = cvtpk(v0, v1); } } }
    if (dump && sample) {
            sample_sel_valu(P, F, b, gh, t0, CTRL[1], lds, tid);
            if (half == 0 && hi == 0) { const LAS float* CSp = (const LAS float*)(lds + SV_CS) + w4 * 128 + r32;
#pragma unroll
                for (int d0 = 0; d0 < 4; ++d0) { const unsigned tp = totp[d0][0]; totp[d0][0] = cvtpk(__uint_as_float(tp << 16) + CSp[d0 * 32], __uint_as_float(tp & 0xffff0000u)); } }
            __syncthreads();
        }
    }
    {
        lbyte* ob = lds + wid * 8192; { int o_ = 0; asm volatile("" : "+v"(o_)); ob += o_; }
#pragma unroll
        for (int q = 0; q < 8; ++q) { const int row0 = crow(2 * q, hi);
#pragma unroll
            for (int d0 = 0; d0 < 4; ++d0) { const unsigned tp = totp[d0][q];
                *(LAS unsigned short*)(ob + row0 * 256 + (d0 * 32 + r32) * 2) = (unsigned short)(tp & 0xffffu);
                *(LAS unsigned short*)(ob + (row0 + 1) * 256 + (d0 * 32 + r32) * 2) = (unsigned short)(tp >> 16); } }
        LDS_WAIT(); asm volatile("" ::: "memory");
        const int rsub = lane >> 4, cs = lane & 15;
        v4u tv[8], gv[8];
#pragma unroll
        for (int i = 0; i < 8; ++i) { const int rw = 4 * i + rsub; const bool ok = ROWOK(rw);
            tv[i] = *(const LAS v4u*)(ob + rw * 256 + cs * 16);
            gv[i] = ok ? *(const v4u*)(F.Z() + (size_t)(rowbase + wrow0 + rw) * ZLD + g2col + cs * 8) : (v4u){0u, 0u, 0u, 0u}; }
#pragma unroll
        for (int i = 0; i < 8; ++i) { const int rw = 4 * i + rsub; const bool ok = ROWOK(rw);
            v4u ov;
#pragma unroll
            for (int e = 0; e < 4; ++e) { const float g0 = __uint_as_float(gv[i][e] << 16), g1 = __uint_as_float(gv[i][e] & 0xffff0000u);
                const float t0_ = __uint_as_float(tv[i][e] << 16), t1_ = __uint_as_float(tv[i][e] & 0xffff0000u);
                ov[e] = cvtpk(t0_ * (g0 / (1.0f + __expf(-g0))), t1_ * (g1 / (1.0f + __expf(-g1)))); }
            if (ok) *(v4u*)(F.MIX() + (size_t)(rowbase + wrow0 + rw) * DM + mixcol + cs * 8) = ov; }
    }
    __syncthreads();
#undef ROWOK
}
#undef KSWZ
#undef SBAR

__device__ __forceinline__ void conv_unit(const Params& P, const Frame& F0, int cu) {
    Frame F = F0; asm volatile("" : "+s"(F.ws));
    int tid = F.wave * 64 + (int)__builtin_amdgcn_mbcnt_hi(~0u, __builtin_amdgcn_mbcnt_lo(~0u, 0u)); asm volatile("" : "+v"(tid));
    const int c = (tid & 63) * 8, rbase = cu * 32 + 4 * (tid >> 6);
    const bool smp = rbase >= MP; const int bs = smp ? ((rbase - MP) >> 2) : 0;
    const int tb = smp ? 0 : (rbase & (PT - 1));
    v4u cc[6], ch[6], cb[4], cg[4]; f32x4 st[2][2];
#pragma unroll
    for (int i = 0; i < 6; ++i) { cc[i] = (v4u){0u, 0u, 0u, 0u}; ch[i] = (v4u){0u, 0u, 0u, 0u};
        if (i >= 2 || (!smp && tb != 0)) { const bf16* zz = F.Z() + (size_t)(rbase - 2 + i) * ZLD; cc[i] = *(const v4u*)(zz + ZC_CC + c); ch[i] = *(const v4u*)(zz + ZC_CH + c); } }
#pragma unroll
    for (int i = 0; i < 2; ++i) { st[i][0] = (f32x4){0.f, 0.f, 0.f, 0.f}; st[i][1] = (f32x4){0.f, 0.f, 0.f, 0.f};
        if (smp) { const float* sp = P.state_conv + ((size_t)bs * 2 + i) * 512 + c; st[i][0] = *(const f32x4*)sp; st[i][1] = *(const f32x4*)(sp + 4); } }
#pragma unroll
    for (int j = 0; j < 4; ++j) { const bf16* z = F.Z() + (size_t)(rbase + j) * ZLD; cb[j] = *(const v4u*)(z + ZC_CB + c); cg[j] = *(const v4u*)(z + ZC_CG + c); }
    float w[3][8];
#pragma unroll
    for (int k = 0; k < 3; ++k) { const f32x4 a0 = *(const f32x4*)(P.w_conv + k * 512 + c), a1 = *(const f32x4*)(P.w_conv + k * 512 + c + 4);
#pragma unroll
        for (int i = 0; i < 4; ++i) { w[k][i] = a0[i]; w[k][4 + i] = a1[i]; } }
    float u[6][8];
#pragma unroll
    for (int i = 0; i < 6; ++i)
#pragma unroll
        for (int e = 0; e < 4; ++e) { u[i][2 * e] = __uint_as_float(cc[i][e] << 16) * __uint_as_float(ch[i][e] << 16); u[i][2 * e + 1] = __uint_as_float(cc[i][e] & 0xffff0000u) * __uint_as_float(ch[i][e] & 0xffff0000u); }
    if (smp) {
#pragma unroll
        for (int i = 0; i < 2; ++i)
#pragma unroll
            for (int e = 0; e < 4; ++e) { u[i][e] = st[i][0][e]; u[i][4 + e] = st[i][1][e]; } }
#pragma unroll
    for (int j = 0; j < 4; ++j) { const int row = rbase + j, t = tb + j;
        float v[8];
#pragma unroll
        for (int i = 0; i < 8; ++i) { const float y = w[0][i] * u[j][i] + w[1][i] * u[j + 1][i] + w[2][i] * u[j + 2][i];
            const unsigned gw = cg[j][i >> 1], bw = cb[j][i >> 1]; const float gt = (i & 1) ? __uint_as_float(gw & 0xffff0000u) : __uint_as_float(gw << 16), bb = (i & 1) ? __uint_as_float(bw & 0xffff0000u) : __uint_as_float(bw << 16);
            v[i] = (gt / (1.0f + __expf(-gt))) * (bb * y); }
        v4u o; o.x = cvtpk(v[0], v[1]); o.y = cvtpk(v[2], v[3]); o.z = cvtpk(v[4], v[5]); o.w = cvtpk(v[6], v[7]);
        *(v4u*)(F.MIX() + (size_t)row * DM + c) = o;
        float* op = nullptr;
        if (!smp) { if (t >= PT - 2) op = P.out + OFF_CONVP + ((size_t)(row >> 11) * 2 + (t - (PT - 2))) * 512 + c; }
        else if (t >= 2) op = P.out + OFF_CONVS + ((size_t)bs * 2 + (t - 2)) * 512 + c;
        if (op) { *(f32x4*)op = (f32x4){u[j + 2][0], u[j + 2][1], u[j + 2][2], u[j + 2][3]}; *(f32x4*)(op + 4) = (f32x4){u[j + 2][4], u[j + 2][5], u[j + 2][6], u[j + 2][7]}; }
    }
}

__device__ __forceinline__ void sample_rows_published(const Frame& F) {
    asm volatile("s_waitcnt vmcnt(0)" ::: "memory"); __syncthreads();
    if (threadIdx.x == 0) { __builtin_amdgcn_fence(__ATOMIC_RELEASE, "agent"); asm volatile("s_waitcnt vmcnt(0)" ::: "memory");
        __hip_atomic_fetch_add(F.QUEUE() + 64 * 12, 1u, __ATOMIC_RELAXED, __HIP_MEMORY_SCOPE_AGENT); }
}
__device__ __forceinline__ void srow_unit(const Params& P, const Frame& F0, int cb) {
    Frame F = F0; asm volatile("" : "+s"(F.ws));
    int tid = F.wave * 64 + (int)__builtin_amdgcn_mbcnt_hi(~0u, __builtin_amdgcn_mbcnt_lo(~0u, 0u)); asm volatile("" : "+v"(tid));
    const int lane = tid & 63, r = lane & 31, k8 = lane >> 5, col0 = cb * 32, k0 = F.wave * 256;
    v4u wa[16]; { const v4u* w = (const v4u*)(F.WoutT() + (size_t)(col0 + r) * DM + k0 + 8 * k8);
#pragma unroll
      for (int i = 0; i < 16; ++i) wa[i] = w[2 * i]; }
    const int orow = tid >> 5, oc = tid & 31;
    const float x0 = P.x_sample[(size_t)orow * DM + col0 + oc], x1 = P.x_sample[(size_t)(orow + 16) * DM + col0 + oc];
    if (tid == 0) { unsigned long long tg0_ = 0; if (PROBE_PHASE >= 90) tg0_ = __builtin_amdgcn_s_memrealtime();
        unsigned sp = 0; while (__hip_atomic_load(F.QUEUE() + 64 * 12, __ATOMIC_RELAXED, __HIP_MEMORY_SCOPE_AGENT) < N_SAMPLE_PRODUCERS) { __builtin_amdgcn_s_sleep(8); if (++sp > (1u << 20)) break; }
        __builtin_amdgcn_fence(__ATOMIC_ACQUIRE, "agent"); asm volatile("s_waitcnt vmcnt(0)" ::: "memory");
        if (PROBE_PHASE >= 90) { volatile LAS unsigned long long* ts_ = (volatile LAS unsigned long long*)(F.lds + LDS_BYTES - 128 + 16); const unsigned long long tn_ = __builtin_amdgcn_s_memrealtime(); ts_[8] = ts_[8] + (tn_ - tg0_); if (ts_[9] == 0) ts_[9] = tn_; ts_[11] = tn_; } }
    __syncthreads();
    f32x16 acc;
#pragma unroll
    for (int i = 0; i < 16; ++i) acc[i] = 0.f;
    { v4u mb[16]; const v4u* m = (const v4u*)(F.MIX() + (size_t)(MP + r) * DM + k0 + 8 * k8);
#pragma unroll
      for (int i = 0; i < 16; ++i) mb[i] = m[2 * i];
#pragma unroll
      for (int i = 0; i < 16; ++i) acc = __builtin_amdgcn_mfma_f32_32x32x16_bf16(__builtin_bit_cast(bf16x8, wa[i]), __builtin_bit_cast(bf16x8, mb[i]), acc, 0, 0, 0); }
    LAS float* red = (LAS float*)F.lds;
#pragma unroll
    for (int i = 0; i < 16; ++i) red[(F.wave * 32 + 8 * (i >> 2) + 4 * k8 + (i & 3)) * 33 + r] = acc[i];
    __syncthreads();
    float* const sss = F.SSP() + (size_t)MP * 32;
#pragma unroll
    for (int h = 0; h < 2; ++h) { const int row = orow + 16 * h; float v = h ? x1 : x0;
#pragma unroll
        for (int w = 0; w < 8; ++w) v += red[(w * 32 + oc) * 33 + row];
        P.out[OFF_YS + (size_t)row * DM + col0 + oc] = v;
        float q = v * v; q += __shfl_xor(q, 1); q += __shfl_xor(q, 2); q += __shfl_xor(q, 4);
        if ((oc & 7) == 0) sss[(size_t)row * 256 + cb * 4 + (oc >> 3)] = q; }
    __syncthreads();
    if (PROBE_PHASE >= 90 && tid == 0) { volatile LAS unsigned long long* ts_ = (volatile LAS unsigned long long*)(F.lds + LDS_BYTES - 128 + 16); ts_[10] = ts_[10] + (__builtin_amdgcn_s_memrealtime() - ts_[11]); }
}

__device__ __forceinline__ void p3_attention(const Params& P, const Frame& F, unsigned xcc) {
    unsigned long long pr_enter_ = 0, pr_srow_ = 0;
    int stage = 0, probe = 0, pending = -1;
    for (;;) {
        int u;
        if (pending >= 0) { u = pending; pending = -1; }
        else {
            int ctl_off = L_CTRL; asm volatile("" : "+v"(ctl_off));
            LAS int* const CTRL = (LAS int*)(F.lds + ctl_off);
            const int qi = stage == 0 ? 0 : (stage == 1 ? 1 + (int)((xcc + (unsigned)probe) & 7u) : 9);
            if (F.wave == 0 && __builtin_amdgcn_mbcnt_hi(~0u, __builtin_amdgcn_mbcnt_lo(~0u, 0u)) == 0u) CTRL[0] = (int)atomicAdd(F.QUEUE() + 64 * qi, 1u);
            __syncthreads();
            const int v = __builtin_amdgcn_readfirstlane(CTRL[0]);
            __syncthreads();
            if (stage == 0) { if (v >= U_SNSA) { stage = 1; continue; } u = v; }
            else if (stage == 1) { if (v >= 24) { if (++probe >= 8) stage = 2; continue; }
                if (v < 16) u = U0_PNSA + v * 8 + (qi - 1);
                else { const int p = v - 16; u = U0_PNSA + (16 + p) * 8 + (qi - 1); pending = U0_PNSA + (31 - p) * 8 + (qi - 1); } }
            else { if (PROBE_PHASE >= 90 && pr_enter_ == 0) pr_enter_ = __builtin_amdgcn_s_memrealtime();
                   if (v >= U_TOTAL - U0_PMEM) break;
                   u = v < U_SMEM ? U0_SMEM + v : (v == U_SMEM ? U0_CONV + MP / 32 : (v < U_SMEM + 1 + U_PMEM ? U0_PMEM + (v - U_SMEM - 1) : (v < U_SMEM + 1 + U_PMEM + MP / 32 ? U0_CONV + (v - U_SMEM - 1 - U_PMEM) : U0_SROW + (v - U_SMEM - 1 - U_PMEM - MP / 32)))); }
        }
        if (PROBE_PHASE >= 90 && u >= U0_SROW && pr_srow_ == 0) pr_srow_ = __builtin_amdgcn_s_memrealtime();
        unsigned long long tu0_ = 0; if (PROBE_PHASE >= 20) tu0_ = __builtin_amdgcn_s_memrealtime();
        const int ukind_ = u < U0_PNSA ? 0 : (u < U0_PMEM ? 1 : (u < U0_SMEM ? 2 : (u < U0_CONV ? 3 : 4)));
#define UNIT_DONE() do { if (PROBE_PHASE >= 50 && PROBE_PHASE - 50 == ukind_ && threadIdx.x == 0) { volatile LAS unsigned long long* ts_ = (volatile LAS unsigned long long*)(F.lds + LDS_BYTES - 128 + 16); ts_[7] = __builtin_amdgcn_s_memrealtime() - ts_[3]; } if (PROBE_PHASE >= 20 && PROBE_PHASE < 50 && PROBE_PHASE - 20 == ukind_ && threadIdx.x == 0) { volatile LAS unsigned long long* tacc = (volatile LAS unsigned long long*)(F.lds + LDS_BYTES - 128 + 16) + 7; *tacc = *tacc + (__builtin_amdgcn_s_memrealtime() - tu0_); } } while (0)
        if (u >= U0_SROW) { srow_unit(P, F, u - U0_SROW); UNIT_DONE(); continue; }
        if (u >= U0_CONV) { conv_unit(P, F, u - U0_CONV); if (u - U0_CONV == MP / 32) { sample_rows_published(F);
                if (PROBE_PHASE >= 90 && threadIdx.x == 0) { volatile LAS unsigned long long* ts_ = (volatile LAS unsigned long long*)(F.lds + LDS_BYTES - 128 + 16); atomicMax((unsigned*)(F.ws + WS_CTL + 262144) + 768, (unsigned)(__builtin_amdgcn_s_memrealtime() - ts_[3])); } }
            UNIT_DONE(); continue; }
        int kind, b, gh, t0, nth, nt;
        if (u < U0_PNSA) { const int per = STOK / SNT; const int bg = u / per, tt = u % per; kind = 1; b = bg >> 1; gh = bg & 1; t0 = tt * SNT; nth = 1; nt = 1; }
        else if (u < U0_PMEM) { const int w = u - U0_PNSA; const int qt = 31 - (w >> 3), bg = w & 7; kind = 0; b = bg >> 1; gh = bg & 1; t0 = qt * 64; nth = 32; nt = 64; }
        else if (u < U0_SMEM) { const int w = u - U0_PMEM; const int qt = w >> 4, bh = w & 15; kind = 2; b = bh >> 2; gh = bh & 3; t0 = qt * 256; nth = 32; nt = 256; }
        else { const int w = u - U0_SMEM; kind = 3; b = w >> 2; gh = w & 3; t0 = 0; nth = 4; nt = 4; }
        attn_unit(P, F, kind, b, gh, t0, nth, nt);
        if (kind & 1) sample_rows_published(F);
        if (PROBE_PHASE >= 90 && (kind & 1) && threadIdx.x == 0) { volatile LAS unsigned long long* ts_ = (volatile LAS unsigned long long*)(F.lds + LDS_BYTES - 128 + 16); const unsigned tq = (unsigned)(__builtin_amdgcn_s_memrealtime() - ts_[3]);
            unsigned* pw = (unsigned*)(F.ws + WS_CTL + 262144); if (kind == 1) { atomicMax(pw + 576, tq); atomicAdd(pw + 640, tq); atomicMax(pw + 832, 1000000u - tq); } else atomicMax(pw + 704, tq); }
        if (u < U0_PMEM && pending < 0 && F.G >= U_SNSA + 8 * 24) stage = 2;
        UNIT_DONE();
    }
    if (PROBE_PHASE >= 90 && threadIdx.x == 0) {
        volatile LAS unsigned long long* ts_ = (volatile LAS unsigned long long*)(F.lds + LDS_BYTES - 128 + 16);
        const unsigned long long t3 = ts_[3], now = __builtin_amdgcn_s_memrealtime();
        unsigned* pw = (unsigned*)(F.ws + WS_CTL + 262144);
        const unsigned te = (unsigned)(pr_enter_ - t3), tb = (unsigned)(now - t3), tsr = pr_srow_ ? (unsigned)(pr_srow_ - t3) : 1000000u;
        atomicMax(pw + 0, te); atomicAdd(pw + 64, (unsigned)ts_[8]); atomicMax(pw + 128, 1000000u - tsr); atomicMax(pw + 192, tb); atomicAdd(pw + 256, te); atomicMax(pw + 320, 1000000u - tb);
        { const unsigned tg = ts_[9] ? (unsigned)(ts_[9] - t3) : 0u; atomicMax(pw + 384, tg); atomicMax(pw + 448, ts_[9] ? 1000000u - tg : 0u); atomicAdd(pw + 512, (unsigned)ts_[10]); }
    }
}
}

__device__ __forceinline__ void p4_sample_rows(const Params& P, Frame& F) {
    float* const sss = F.SSP() + (size_t)MP * 32;
    for (int cb = F.vcu; cb < DM / 8; cb += F.G) {
        { const v4u* src = (const v4u*)(F.MIX() + (size_t)MP * DM); LAS v4u* dst = (LAS v4u*)F.lds;
#pragma unroll 4
          for (int i = 0; i < 16; ++i) dst[F.tid + 512 * i] = src[F.tid + 512 * i]; }
        __syncthreads();
        const int col = cb * 8 + F.wave;
        v4u wv[4]; { const v4u* w = (const v4u*)(F.WoutT() + (size_t)col * DM) + F.lane * 4;
#pragma unroll
          for (int j = 0; j < 4; ++j) wv[j] = w[j]; }
        float mine = 0.f;
        for (int row = 0; row < 32; ++row) { const LAS v4u* a = (const LAS v4u*)F.lds + row * 256 + F.lane * 4; float s = 0.f;
#pragma unroll
            for (int j = 0; j < 4; ++j) { const v4u av = a[j];
#pragma unroll
                for (int e = 0; e < 4; ++e) { s += __uint_as_float(av[e] << 16) * __uint_as_float(wv[j][e] << 16); s += __uint_as_float(av[e] & 0xffff0000u) * __uint_as_float(wv[j][e] & 0xffff0000u); } }
            s = wave_sum(s); if (F.lane == row) mine = s; }
        LAS float* sq = (LAS float*)(F.lds + 131072);
        if (F.lane < 32) { const float v = mine + P.x_sample[(size_t)F.lane * DM + col]; P.out[OFF_YS + (size_t)F.lane * DM + col] = v; sq[F.wave * 32 + F.lane] = v * v; }
        __syncthreads();
        if (F.tid < 32) { float q = 0.f;
#pragma unroll
            for (int w = 0; w < 8; ++w) q += sq[w * 32 + F.tid];
            sss[(size_t)F.tid * 256 + cb] = q; }
        __syncthreads();
    }
}

__device__ __forceinline__ void p5_final_norm(const Params& P, Frame& F, int first_row) {
    const int gw = F.vcu * NWAVES + F.wave, NGW = F.G * NWAVES;
    for (int m = first_row + gw; m < MALL; m += NGW) {
        float* row = m < MP ? P.out + OFF_YP + (size_t)m * DM : P.out + OFF_YS + (size_t)(m - MP) * DM;
        float ss;
        if (m < MP) { ss = F.lane < 32 ? F.SSP()[(size_t)m * 32 + F.lane] : 0.f; }
        else { const float* sp = F.SSP() + (size_t)MP * 32 + (size_t)(m - MP) * 256; ss = (sp[F.lane] + sp[64 + F.lane]) + (sp[128 + F.lane] + sp[192 + F.lane]); }
        const float rstd = 1.0f / sqrtf(wave_sum(ss) * (1.f / DM) + NORM_EPS);
        f32x4* xr = (f32x4*)row + F.lane; const f32x4* gr = (const f32x4*)P.final_g + F.lane;
#pragma unroll
        for (int j = 0; j < 8; ++j) { f32x4 v = xr[64 * j]; const f32x4 g = gr[64 * j]; v = v * rstd * g; xr[64 * j] = v; }
    }
}

#define RLX_AGENT __ATOMIC_RELAXED, __HIP_MEMORY_SCOPE_AGENT
#define XB_TMO      128
#define XB_XCNT(j)  (256  + 64 * (j))
#define XB_XSUB(j)  (1280 + 64 * (j))
#define XB_XGEN(j)  (2304 + 64 * (j))
#define XB_TOP      3328
#define XB_TOPGEN   3392
#define XCD_BAR_WORDS 3456
#define XB_SPIN_CAP (1u << 18)

__device__ __forceinline__ unsigned xb_ld(unsigned* p)              { return __hip_atomic_load(p, __ATOMIC_RELAXED, __HIP_MEMORY_SCOPE_AGENT); }
__device__ __forceinline__ unsigned xb_add(unsigned* p, unsigned v) { return __hip_atomic_fetch_add(p, v, __ATOMIC_RELAXED, __HIP_MEMORY_SCOPE_AGENT); }
__device__ __forceinline__ unsigned xb_xcc_id() { return (unsigned)__builtin_amdgcn_s_getreg((3 << 11) | 20) & 0xFu; }
#define XB_SPIN(cond, bar) do { unsigned _sp = 0; while (cond) { __builtin_amdgcn_s_sleep(1); \
    if ((++_sp & 255u) == 0u) { if (xb_ld(&(bar)[XB_TMO])) break; if (_sp > XB_SPIN_CAP) { atomicAdd(&(bar)[XB_TMO], 1u); break; } } } } while (0)

struct XcdBarrier {
    unsigned* bar; unsigned x;
    volatile LAS unsigned* st;
};

__device__ __forceinline__ XcdBarrier xcd_barrier_post(unsigned* bar, volatile LAS unsigned* st) {
    XcdBarrier b; b.bar = bar; b.x = xb_xcc_id(); b.st = st;
    if (threadIdx.x == 0) (void)xb_add(&bar[XB_XCNT(b.x)], 1u);
    return b;
}
__device__ __forceinline__ void xcd_barrier_complete(unsigned* bar, unsigned x, unsigned& nloc, unsigned& nx) {
    const unsigned G = gridDim.x * gridDim.y * gridDim.z;
    unsigned sum, cnt, mine, sp = 0u;
    for (;;) {
        sum = 0u; cnt = 0u; mine = 0u;
#pragma unroll
        for (unsigned j = 0; j < 16; ++j) { const unsigned c = xb_ld(&bar[XB_XCNT(j)]); sum += c; cnt += (c > 0u) ? 1u : 0u; mine = (j == x) ? c : mine; }
        if (sum == G) break;
        __builtin_amdgcn_s_sleep(1);
        if ((++sp & 255u) == 0u) { if (xb_ld(&bar[XB_TMO])) break; if (sp > XB_SPIN_CAP) { atomicAdd(&bar[XB_TMO], 1u); break; } }
    }
    nloc = mine > 0u ? mine : 1u; nx = cnt > 0u ? cnt : 1u;
}

__device__ __forceinline__ void xcd_barrier(const XcdBarrier& b) {
    asm volatile("s_waitcnt vmcnt(0)" ::: "memory");
    __syncthreads();
    if (threadIdx.x == 0) {
        unsigned* bar = b.bar;
        __builtin_amdgcn_s_waitcnt(0);
        unsigned nloc = b.st[0], nx = b.st[1];
        if (nloc == 0u) { xcd_barrier_complete(bar, b.x, nloc, nx); b.st[0] = nloc; b.st[1] = nx; }
        const unsigned old = xb_add(&bar[XB_XSUB(b.x)], 1u);
        const unsigned gen = old / nloc;
        if (old + 1u == (gen + 1u) * nloc) {
            __builtin_amdgcn_fence(__ATOMIC_RELEASE, "agent");
            asm volatile("s_waitcnt vmcnt(0)" ::: "memory");
            const unsigned og = xb_add(&bar[XB_TOP], 1u);
            const unsigned tg = og / nx;
            if (og + 1u == (tg + 1u) * nx) xb_add(&bar[XB_TOPGEN], 1u);
            else XB_SPIN(xb_ld(&bar[XB_TOPGEN]) == tg, bar);
            __builtin_amdgcn_fence(__ATOMIC_ACQUIRE, "agent");
            xb_add(&bar[XB_XGEN(b.x)], 1u);
            asm volatile("s_waitcnt vmcnt(0)" ::: "memory");
        } else {
            XB_SPIN(xb_ld(&bar[XB_XGEN(b.x)]) == gen, bar);
            __builtin_amdgcn_fence(__ATOMIC_ACQUIRE, "agent");
            asm volatile("s_waitcnt vmcnt(0)" ::: "memory");
        }
    }
    __syncthreads();
}

constexpr int L_BAR = LDS_BYTES - 128;
constexpr size_t CTL_BAR_OFF = 65536;
#ifndef PROBE_PHASE
#define PROBE_PHASE -1
#endif
constexpr int N_PHASES = 6;
__global__ void __launch_bounds__(NTHREADS, 2) fwd_megakernel(Params P) {
    extern __shared__ __attribute__((aligned(16))) unsigned char lds_raw[];
    Frame F;
    F.lds = (lbyte*)lds_raw;
    F.tid = threadIdx.x; F.lane = F.tid & 63; F.wave = __builtin_amdgcn_readfirstlane(F.tid >> 6);
    F.G = gridDim.x; { const int bx = blockIdx.x; F.vcu = (F.G % 8 == 0) ? (bx % 8) * (F.G / 8) + bx / 8 : bx; }
    F.ws = P.ws;
    { LAS unsigned* z = (LAS unsigned*)(F.lds + L_BAR); if (F.tid < 32) z[F.tid] = 0u; }
    __syncthreads();
    XcdBarrier bar = xcd_barrier_post((unsigned*)(P.ws + WS_CTL + CTL_BAR_OFF), (volatile LAS unsigned*)(F.lds + L_BAR));
    const int lo = P.ph_lo, hi = P.ph_hi;
#ifndef PH_MASK
#define PH_MASK 63
#endif
#define IN(k) (((PH_MASK >> (k)) & 1) && lo <= (k) && (k) < hi)
#define STAMP(k) do { if (PROBE_PHASE >= 0 && F.tid == 0) ((volatile LAS unsigned long long*)(F.lds + L_BAR + 16))[k] = __builtin_amdgcn_s_memrealtime(); } while (0)
#define SEAM(k) do { if (IN(k) && IN((k) + 1)) { xcd_barrier(bar); } STAMP((k) + 1); } while (0)
    STAMP(0);

    if (IN(0)) { p0_prologue(P, F); }
    if (PROBE_PHASE == 80 && F.tid == 0) ((volatile LAS unsigned long long*)(F.lds + L_BAR + 16))[7] = __builtin_amdgcn_s_memrealtime();
    if (PROBE_PHASE >= 110 && PROBE_PHASE <= 112) { __syncthreads(); if (F.tid == 0) { volatile LAS unsigned long long* ts_ = (volatile LAS unsigned long long*)(F.lds + L_BAR + 16); const unsigned tb = (unsigned)(__builtin_amdgcn_s_memrealtime() - ts_[0]);
        unsigned* pw = (unsigned*)(P.ws + WS_CTL + 262144); atomicAdd(pw + 896, tb); atomicMax(pw + 960, 1000000u - tb); atomicMax(pw + 1024, tb); } }
    SEAM(0);
    if (IN(1)) {
        pg8::Gemm g{F.HN(), F.WinT(), MPAD, ZLD, DM, F.HM(), F.WmemT()}; pg8::DualOrder S; S.init(MPAD, ZLD, 1024, 1024, F.G, (int)blockIdx.x);
        pg8::EpiDual E{pg8::EpiIn{F.Z(), F.QNR(), P.out, F.ROPE(), P.a_cmp, F.POOLP(), F.KV4()}, pg8::EpiMem{P.out, F.MKV()}};
        const int nun = S.n0 + S.n1, rem = nun % F.G, c = (int)blockIdx.x, NI = SBATCH * 256;
        const int nidle = rem ? F.G - rem : F.G, kp = rem ? c - rem : c;
        if (kp >= 0 && (kp & 1) == 0) pool_sample(P, F, kp, nidle, NI);
        pg8::gemm_phase<pg8::EpiDual, pg8::DualOrder, true, true>(F.lds, g, S, E);
        if (kp >= 0 && (kp & 1) == 1) pool_sample(P, F, kp, nidle, NI);
    }
    if (PROBE_PHASE >= 113 && PROBE_PHASE <= 115) { __syncthreads(); if (F.tid == 0) { volatile LAS unsigned long long* ts_ = (volatile LAS unsigned long long*)(F.lds + L_BAR + 16); const unsigned tb = (unsigned)(__builtin_amdgcn_s_memrealtime() - ts_[1]);
        unsigned* pw = (unsigned*)(P.ws + WS_CTL + 262144); atomicAdd(pw + 896, tb); atomicMax(pw + 960, 1000000u - tb); atomicMax(pw + 1024, tb); } }
    SEAM(1);
    if (IN(2)) { p2_cmp_finalize(P, F); }
    if (PROBE_PHASE >= 116 && PROBE_PHASE <= 118) { __syncthreads(); if (F.tid == 0) { volatile LAS unsigned long long* ts_ = (volatile LAS unsigned long long*)(F.lds + L_BAR + 16); const unsigned tb = (unsigned)(__builtin_amdgcn_s_memrealtime() - ts_[2]);
        unsigned* pw = (unsigned*)(P.ws + WS_CTL + 262144); atomicAdd(pw + 896, tb); atomicMax(pw + 960, 1000000u - tb); atomicMax(pw + 1024, tb); } }
    SEAM(2);
    if (IN(3)) { att::p3_attention(P, F, bar.x); }
    SEAM(3);
    const bool fuse_norm = (F.G == 256);
    if (IN(4)) {
        if (fuse_norm) p5_final_norm(P, F, MP);
        pg8::Gemm g{F.MIX(), F.WoutT(), MP, DM, DM, nullptr, nullptr}; pg8::StaticOrder S; S.init(MP, DM, F.G, (int)blockIdx.x);
        if (fuse_norm) { pg8::EpiOutNorm E{P.x_prompt, P.out, P.final_g, F.XB(), (unsigned*)(P.ws + WS_CTL + 131072)};
            pg8::gemm_phase<pg8::EpiOutNorm, pg8::StaticOrder, false, true>(F.lds, g, S, E); }
        else { pg8::EpiOut E{P.x_prompt, P.out, F.SSP()};
            pg8::gemm_phase<pg8::EpiOut, pg8::StaticOrder, false, true>(F.lds, g, S, E); }
    }
    if (!fuse_norm) { SEAM(4); if (IN(5)) p5_final_norm(P, F, 0); }
    if ((PROBE_PHASE >= 0 && PROBE_PHASE <= 10) || PROBE_PHASE == 13 || PROBE_PHASE >= 20) {
        __syncthreads(); STAMP(6); __syncthreads();
        volatile LAS unsigned long long* ts = (volatile LAS unsigned long long*)(F.lds + L_BAR + 16);
        unsigned long long pv_[6] = {0, 0, 0, 0, 0, 0};
        if (PROBE_PHASE >= 90) { const unsigned* pw = (const unsigned*)(P.ws + WS_CTL + 262144);
            pv_[0] = __hip_atomic_load(pw + 0, __ATOMIC_RELAXED, __HIP_MEMORY_SCOPE_AGENT); pv_[1] = __hip_atomic_load(pw + 64, __ATOMIC_RELAXED, __HIP_MEMORY_SCOPE_AGENT) / 256u;
            pv_[2] = 1000000u - __hip_atomic_load(pw + 128, __ATOMIC_RELAXED, __HIP_MEMORY_SCOPE_AGENT); pv_[3] = __hip_atomic_load(pw + 192, __ATOMIC_RELAXED, __HIP_MEMORY_SCOPE_AGENT);
            pv_[4] = __hip_atomic_load(pw + 256, __ATOMIC_RELAXED, __HIP_MEMORY_SCOPE_AGENT) / 256u; pv_[5] = 1000000u - __hip_atomic_load(pw + 320, __ATOMIC_RELAXED, __HIP_MEMORY_SCOPE_AGENT); }
        const unsigned long long dt = PROBE_PHASE == 90 ? pv_[0] + 100000ull * (pv_[1] / 400) : PROBE_PHASE == 91 ? pv_[2] + 100000ull * (pv_[4] / 400) : PROBE_PHASE == 92 ? pv_[3] + 100000ull * (pv_[5] / 400) : PROBE_PHASE == 100 ? (unsigned long long)__hip_atomic_load((const unsigned*)(P.ws + WS_CTL + 262144) + 384, __ATOMIC_RELAXED, __HIP_MEMORY_SCOPE_AGENT) : PROBE_PHASE == 101 ? 1000000ull - __hip_atomic_load((const unsigned*)(P.ws + WS_CTL + 262144) + 448, __ATOMIC_RELAXED, __HIP_MEMORY_SCOPE_AGENT) : PROBE_PHASE == 102 ? (unsigned long long)(__hip_atomic_load((const unsigned*)(P.ws + WS_CTL + 262144) + 512, __ATOMIC_RELAXED, __HIP_MEMORY_SCOPE_AGENT) / 256u) * 4 : PROBE_PHASE == 103 ? (unsigned long long)__hip_atomic_load((const unsigned*)(P.ws + WS_CTL + 262144) + 576, __ATOMIC_RELAXED, __HIP_MEMORY_SCOPE_AGENT) : PROBE_PHASE == 104 ? (unsigned long long)(__hip_atomic_load((const unsigned*)(P.ws + WS_CTL + 262144) + 640, __ATOMIC_RELAXED, __HIP_MEMORY_SCOPE_AGENT) / 64u) : PROBE_PHASE == 105 ? (unsigned long long)__hip_atomic_load((const unsigned*)(P.ws + WS_CTL + 262144) + 704, __ATOMIC_RELAXED, __HIP_MEMORY_SCOPE_AGENT) : PROBE_PHASE == 106 ? (unsigned long long)__hip_atomic_load((const unsigned*)(P.ws + WS_CTL + 262144) + 768, __ATOMIC_RELAXED, __HIP_MEMORY_SCOPE_AGENT) : PROBE_PHASE == 107 ? 1000000ull - __hip_atomic_load((const unsigned*)(P.ws + WS_CTL + 262144) + 832, __ATOMIC_RELAXED, __HIP_MEMORY_SCOPE_AGENT) : (PROBE_PHASE == 110 || PROBE_PHASE == 113 || PROBE_PHASE == 116) ? (unsigned long long)(__hip_atomic_load((const unsigned*)(P.ws + WS_CTL + 262144) + 896, __ATOMIC_RELAXED, __HIP_MEMORY_SCOPE_AGENT) / 256u) : (PROBE_PHASE == 111 || PROBE_PHASE == 114 || PROBE_PHASE == 117) ? 1000000ull - __hip_atomic_load((const unsigned*)(P.ws + WS_CTL + 262144) + 960, __ATOMIC_RELAXED, __HIP_MEMORY_SCOPE_AGENT) : (PROBE_PHASE == 112 || PROBE_PHASE == 115 || PROBE_PHASE == 118) ? (unsigned long long)__hip_atomic_load((const unsigned*)(P.ws + WS_CTL + 262144) + 1024, __ATOMIC_RELAXED, __HIP_MEMORY_SCOPE_AGENT) : PROBE_PHASE == 93 ? pv_[3] : PROBE_PHASE == 94 ? pv_[0] : PROBE_PHASE == 95 ? pv_[1] * 16 : PROBE_PHASE == 96 ? pv_[2] : PROBE_PHASE == 97 ? pv_[4] : PROBE_PHASE == 98 ? pv_[5] : PROBE_PHASE == 80 ? ts[1] - ts[7] : (PROBE_PHASE == 10 || PROBE_PHASE == 13 || PROBE_PHASE >= 20) ? ts[7] : ts[PROBE_PHASE + 1] - ts[PROBE_PHASE], t0 = __builtin_amdgcn_s_memrealtime();
        while (__builtin_amdgcn_s_memrealtime() - t0 < dt) __builtin_amdgcn_s_sleep(8);
    }
#undef IN
#undef SEAM
}

#ifndef MK_N_LAUNCHES
#define MK_N_LAUNCHES 1
#endif
extern "C" void kernel_launch(void* const* d_in, const int* in_sizes, int n_in, void* d_out, int out_size, void* d_ws, size_t ws_size, hipStream_t stream) {
    static int grid = 0;
    if (grid == 0) {
        if (n_in != 17 || (size_t)out_size != OFF_END || ws_size < WS_END) { fprintf(stderr, "kernel_launch: unexpected shapes (n_in %d out %d ws %zu)\n", n_in, out_size, ws_size); grid = -1; return; }
        int dev = 0, cus = 0, per_cu = 0;
        if (hipGetDevice(&dev) != hipSuccess || hipDeviceGetAttribute(&cus, hipDeviceAttributeMultiprocessorCount, dev) != hipSuccess) { grid = -1; return; }
        if (hipFuncSetAttribute((const void*)fwd_megakernel, hipFuncAttributeMaxDynamicSharedMemorySize, LDS_BYTES) != hipSuccess) { fprintf(stderr, "kernel_launch: hipFuncSetAttribute failed\n"); grid = -1; return; }
        if (hipOccupancyMaxActiveBlocksPerMultiprocessor(&per_cu, (const void*)fwd_megakernel, NTHREADS, LDS_BYTES) != hipSuccess || per_cu < 1) { fprintf(stderr, "kernel_launch: occupancy query says %d\n", per_cu); (void)hipGetLastError(); grid = -1; return; }
        grid = cus;
    }
    if (grid < 0) return;
    (void)hipMemsetAsync((char*)d_ws + WS_CTL, 0, CTL_BYTES, stream);
    Params p{};
    p.x_prompt = (const float*)d_in[0]; p.x_sample = (const float*)d_in[1]; p.cache_kv = (const float*)d_in[2]; p.cache_win = (const float*)d_in[3];
    p.state_conv = (const float*)d_in[4]; p.cache_mem = (const float*)d_in[5]; p.page_table = (const int*)d_in[6]; p.mem_prompt = (const float*)d_in[7];
    p.norm_g = (const float*)d_in[8]; p.w_in = (const float*)d_in[9]; p.w_conv = (const float*)d_in[10]; p.a_cmp = (const float*)d_in[11]; p.w_cmp = (const float*)d_in[12];
    p.mem_norm_g = (const float*)d_in[13]; p.w_mem_kv = (const float*)d_in[14]; p.w_out = (const float*)d_in[15]; p.final_g = (const float*)d_in[16];
    p.out = (float*)d_out; p.ws = (unsigned char*)d_ws;
#if MK_N_LAUNCHES == 1
    p.ph_lo = 0; p.ph_hi = N_PHASES;
    void* args[] = {&p};
    hipError_t e = hipLaunchCooperativeKernel((const void*)fwd_megakernel, dim3(grid), dim3(NTHREADS), args, LDS_BYTES, stream);
    if (e != hipSuccess) fprintf(stderr, "kernel_launch: cooperative launch failed: %s (grid %d)\n", hipGetErrorString(e), grid);
#else
    for (int k = 0; k < N_PHASES; ++k) { p.ph_lo = k; p.ph_hi = k + 1; hipLaunchKernelGGL(fwd_megakernel, dim3(grid), dim3(NTHREADS), LDS_BYTES, stream, p); }
#endif
}
```
